# Optimizing an MI355X kernel written in HIP

```python
import math
import jax, jax.numpy as jnp
from jax import lax
import numpy as np

D_MODEL = 1024
BATCH = 4
SEQ = 8192
DEPTH = 4

MEM_TOKENS = 256
N_MIXERS = 2
MIX_WIDTH = 2 * D_MODEL
XATTN_WIDTH = MIX_WIDTH // 4
TOKEN_WIDTH = MIX_WIDTH - XATTN_WIDTH
XATTN_HEADS = 4
XATTN_HEAD_DIM = XATTN_WIDTH // XATTN_HEADS
S5_GROUP = 16
S5_STATE = 64
S5_GROUPS = TOKEN_WIDTH // S5_GROUP
GDN_HEAD_DIM = 128
GDN_V_HEADS = TOKEN_WIDTH // GDN_HEAD_DIM
GDN_QK_HEADS = GDN_V_HEADS // 2
GDN_QK_WIDTH = GDN_QK_HEADS * GDN_HEAD_DIM
CONV_WIDTH = 4
CHUNK = 64
NORM_EPS = 1e-6
S5_IN = 2 * TOKEN_WIDTH + 2 * XATTN_WIDTH
GDN_IN = 2 * GDN_QK_WIDTH + TOKEN_WIDTH + 2 * GDN_V_HEADS + TOKEN_WIDTH + 2 * XATTN_WIDTH

kernel_name = "hybrid_s5_gdn_xattn_trunk"


def rmsnorm(x, w):
    xf = x.astype(jnp.float32)
    xf = xf * lax.rsqrt(jnp.mean(xf * xf, axis=-1, keepdims=True) + NORM_EPS)
    return xf.astype(x.dtype) * w


def l2norm(x):
    xf = x.astype(jnp.float32)
    return xf * lax.rsqrt(jnp.sum(xf * xf, axis=-1, keepdims=True) + NORM_EPS)


def causal_conv(x, w):
    k = w.shape[0]
    length = x.shape[1]
    xp = jnp.pad(x, ((0, 0), (k - 1, 0), (0, 0)))
    return sum(xp[:, j:j + length] * w[j] for j in range(k))


def cross_attn(q, mem_h, w_kv):
    bsz, length, _ = q.shape
    kv = mem_h @ w_kv
    k, v = jnp.split(kv, 2, axis=-1)
    q = q.reshape(bsz, length, XATTN_HEADS, XATTN_HEAD_DIM)
    k = k.reshape(bsz, -1, XATTN_HEADS, XATTN_HEAD_DIM)
    v = v.reshape(bsz, -1, XATTN_HEADS, XATTN_HEAD_DIM)
    s = jnp.einsum('blhd,bmhd->bhlm', q, k).astype(jnp.float32) * (XATTN_HEAD_DIM ** -0.5)
    p = jax.nn.softmax(s, axis=-1).astype(v.dtype)
    o = jnp.einsum('bhlm,bmhd->blhd', p, v)
    return o.reshape(bsz, length, XATTN_WIDTH)


def _s5_combine(c1, c2):
    a1r, a1i, b1r, b1i = c1
    a2r, a2i, b2r, b2i = c2
    ar = a1r * a2r - a1i * a2i
    ai = a1r * a2i + a1i * a2r
    br = a2r * b1r - a2i * b1i + b2r
    bi = a2r * b1i + a2i * b1r + b2i
    return (ar, ai, br, bi)


def s5_mixer(u, lam_re, lam_im, log_step, b_re, b_im, c_re, c_im, d, w_glu, b_glu):
    bsz, length, _ = u.shape
    f32 = jnp.float32
    uf = u.astype(f32)
    ug = uf.reshape(bsz, length, S5_GROUPS, S5_GROUP)
    dt = jnp.exp(log_step.astype(f32))[:, None]
    lr, li = lam_re.astype(f32), lam_im.astype(f32)
    mag = jnp.exp(lr * dt)
    ar, ai = mag * jnp.cos(li * dt), mag * jnp.sin(li * dt)
    den = lr * lr + li * li
    nr, ni = ar - 1.0, ai
    cr, ci = (nr * lr + ni * li) / den, (ni * lr - nr * li) / den
    br, bi = b_re.astype(f32), b_im.astype(f32)
    bbar_re = cr[..., None] * br - ci[..., None] * bi
    bbar_im = cr[..., None] * bi + ci[..., None] * br
    bu_re = jnp.einsum('blgh,gph->blgp', ug, bbar_re)
    bu_im = jnp.einsum('blgh,gph->blgp', ug, bbar_im)
    a_re = jnp.broadcast_to(ar, (1, length, S5_GROUPS, S5_STATE))
    a_im = jnp.broadcast_to(ai, (1, length, S5_GROUPS, S5_STATE))
    _, _, x_re, x_im = lax.associative_scan(_s5_combine, (a_re, a_im, bu_re, bu_im), axis=1)
    y = (jnp.einsum('blgp,ghp->blgh', x_re, c_re.astype(f32))
         - jnp.einsum('blgp,ghp->blgh', x_im, c_im.astype(f32)))
    y = y.reshape(bsz, length, TOKEN_WIDTH) + d.astype(f32) * uf
    y = jax.nn.gelu(y)
    y = y * jax.nn.sigmoid(y @ w_glu.astype(f32) + b_glu.astype(f32))
    return y.astype(u.dtype)


def gated_delta_chunked(q, k, v, g, beta):
    f32 = jnp.float32
    bsz, length, heads, dk = k.shape
    dv = v.shape[-1]
    n = length // CHUNK

    def to_chunks(t):
        return t.astype(f32).reshape(bsz, n, CHUNK, heads, -1).transpose(1, 0, 3, 2, 4)

    q, k, v = to_chunks(q), to_chunks(k), to_chunks(v)
    g = g.astype(f32).reshape(bsz, n, CHUNK, heads).transpose(1, 0, 3, 2)
    beta = beta.astype(f32).reshape(bsz, n, CHUNK, heads).transpose(1, 0, 3, 2)
    g = jnp.cumsum(g, axis=-1)
    k_beta = k * beta[..., None]
    v_beta = v * beta[..., None]
    causal = jnp.tril(jnp.ones((CHUNK, CHUNK), dtype=bool))
    strict = jnp.tril(jnp.ones((CHUNK, CHUNK), dtype=bool), -1)
    decay = jnp.exp(jnp.where(causal, g[..., :, None] - g[..., None, :], -jnp.inf))
    l_mat = jnp.where(strict, jnp.einsum('nbhid,nbhjd->nbhij', k_beta, k) * decay, 0.0)
    eye = jnp.broadcast_to(jnp.eye(CHUNK, dtype=f32), l_mat.shape)
    t_mat = lax.linalg.triangular_solve(l_mat, eye, left_side=True, lower=True, unit_diagonal=True)
    u = jnp.einsum('nbhij,nbhjd->nbhid', t_mat, v_beta)
    w = jnp.einsum('nbhij,nbhjd->nbhid', t_mat, k_beta * jnp.exp(g)[..., None])
    intra = jnp.where(causal, jnp.einsum('nbhid,nbhjd->nbhij', q, k) * decay, 0.0)

    def step(state, xs):
        q_c, k_c, u_c, w_c, g_c, a_c = xs
        v_new = u_c - jnp.einsum('bhcd,bhde->bhce', w_c, state)
        o = (jnp.einsum('bhcd,bhde->bhce', q_c * jnp.exp(g_c)[..., None], state)
             + jnp.einsum('bhij,bhje->bhie', a_c, v_new))
        g_last = g_c[..., -1]
        k_dec = k_c * jnp.exp(g_last[..., None] - g_c)[..., None]
        state = state * jnp.exp(g_last)[..., None, None] + jnp.einsum('bhcd,bhce->bhde', k_dec, v_new)
        return state, o

    s0 = jnp.zeros((bsz, heads, dk, dv), dtype=f32)
    _, o = lax.scan(step, s0, (q, k, u, w, g, intra))
    return o.transpose(1, 0, 3, 2, 4).reshape(bsz, length, heads, dv)


def gdn_mixer(qkv, a, b, gate, conv_w, a_log, dt_bias, norm_w):
    bsz, length, _ = qkv.shape
    f32 = jnp.float32
    qkv = jax.nn.silu(causal_conv(qkv, conv_w))
    q, k, v = jnp.split(qkv, [GDN_QK_WIDTH, 2 * GDN_QK_WIDTH], axis=-1)
    rep = GDN_V_HEADS // GDN_QK_HEADS
    q = jnp.repeat(l2norm(q.reshape(bsz, length, GDN_QK_HEADS, GDN_HEAD_DIM)), rep, axis=2) * (GDN_HEAD_DIM ** -0.5)
    k = jnp.repeat(l2norm(k.reshape(bsz, length, GDN_QK_HEADS, GDN_HEAD_DIM)), rep, axis=2)
    v = v.reshape(bsz, length, GDN_V_HEADS, GDN_HEAD_DIM)
    g = -jnp.exp(a_log.astype(f32)) * jax.nn.softplus(a.astype(f32) + dt_bias.astype(f32))
    beta = jax.nn.sigmoid(b.astype(f32))
    o = gated_delta_chunked(q, k, v, g, beta).astype(qkv.dtype)
    o = rmsnorm(o, norm_w).reshape(bsz, length, TOKEN_WIDTH)
    return o * jax.nn.silu(gate)


def setup_inputs(seed: int = 0) -> dict:
    key = jax.random.key(seed)
    ks = jax.random.split(key, 24)
    n_s5 = (DEPTH + 1) // 2
    n_gdn = DEPTH // 2
    nrm = jax.random.normal
    f32 = jnp.float32
    x = nrm(ks[0], (BATCH, SEQ, D_MODEL), f32)
    mem = nrm(ks[1], (BATCH, MEM_TOKENS, D_MODEL), f32)
    norm_w = 1.0 + 0.02 * nrm(ks[2], (DEPTH, D_MODEL), f32)
    w_out = nrm(ks[3], (DEPTH, MIX_WIDTH, D_MODEL), f32) * MIX_WIDTH ** -0.5
    mem_norm_w = 1.0 + 0.02 * nrm(ks[4], (DEPTH, D_MODEL), f32)
    w_mem_kv = nrm(ks[5], (DEPTH, D_MODEL, 2 * XATTN_WIDTH), f32) * D_MODEL ** -0.5
    s5_w_in = nrm(ks[6], (n_s5, D_MODEL, S5_IN), f32) * D_MODEL ** -0.5
    s5_lambda_re = -0.5 + 0.01 * nrm(ks[7], (n_s5, S5_GROUPS, S5_STATE), f32)
    s5_lambda_im = (math.pi * jnp.arange(S5_STATE, dtype=f32)
                    + 0.01 * nrm(ks[8], (n_s5, S5_GROUPS, S5_STATE), f32))
    s5_log_step = jax.random.uniform(ks[9], (n_s5, S5_GROUPS), f32, math.log(1e-3), math.log(1e-1))
    s5_b_re = nrm(ks[10], (n_s5, S5_GROUPS, S5_STATE, S5_GROUP), f32) * (2 * S5_GROUP) ** -0.5
    s5_b_im = nrm(ks[11], (n_s5, S5_GROUPS, S5_STATE, S5_GROUP), f32) * (2 * S5_GROUP) ** -0.5
    s5_c_re = nrm(ks[12], (n_s5, S5_GROUPS, S5_GROUP, S5_STATE), f32) * S5_STATE ** -0.5
    s5_c_im = nrm(ks[13], (n_s5, S5_GROUPS, S5_GROUP, S5_STATE), f32) * S5_STATE ** -0.5
    s5_d = nrm(ks[14], (n_s5, TOKEN_WIDTH), f32)
    s5_w_glu = nrm(ks[15], (n_s5, TOKEN_WIDTH, TOKEN_WIDTH), f32) * TOKEN_WIDTH ** -0.5
    s5_b_glu = 0.01 * nrm(ks[16], (n_s5, TOKEN_WIDTH), f32)
    gdn_w_in = nrm(ks[17], (n_gdn, D_MODEL, GDN_IN), f32) * D_MODEL ** -0.5
    gdn_conv_w = nrm(ks[18], (n_gdn, CONV_WIDTH, 2 * GDN_QK_WIDTH + TOKEN_WIDTH), f32) * CONV_WIDTH ** -0.5
    gdn_a_log = jnp.log(jax.random.uniform(ks[19], (n_gdn, GDN_V_HEADS), f32, 1.0, 16.0))
    dt = jnp.exp(jax.random.uniform(ks[20], (n_gdn, GDN_V_HEADS), f32, math.log(1e-3), math.log(1e-1)))
    gdn_dt_bias = dt + jnp.log(-jnp.expm1(-dt))
    gdn_norm_w = 1.0 + 0.02 * nrm(ks[21], (n_gdn, GDN_HEAD_DIM), f32)
    final_norm_w = 1.0 + 0.02 * nrm(ks[22], (D_MODEL,), f32)
    return {"x": x, "mem": mem, "norm_w": norm_w, "w_out": w_out, "mem_norm_w": mem_norm_w,
            "w_mem_kv": w_mem_kv, "s5_w_in": s5_w_in, "s5_lambda_re": s5_lambda_re,
            "s5_lambda_im": s5_lambda_im, "s5_log_step": s5_log_step, "s5_b_re": s5_b_re,
            "s5_b_im": s5_b_im, "s5_c_re": s5_c_re, "s5_c_im": s5_c_im, "s5_d": s5_d,
            "s5_w_glu": s5_w_glu, "s5_b_glu": s5_b_glu, "gdn_w_in": gdn_w_in,
            "gdn_conv_w": gdn_conv_w, "gdn_a_log": gdn_a_log, "gdn_dt_bias": gdn_dt_bias,
            "gdn_norm_w": gdn_norm_w, "final_norm_w": final_norm_w}


def reference(x, mem, norm_w, w_out, mem_norm_w, w_mem_kv, s5_w_in, s5_lambda_re, s5_lambda_im,
              s5_log_step, s5_b_re, s5_b_im, s5_c_re, s5_c_im, s5_d, s5_w_glu, s5_b_glu,
              gdn_w_in, gdn_conv_w, gdn_a_log, gdn_dt_bias, gdn_norm_w, final_norm_w):
    for i in range(DEPTH):
        j = i // N_MIXERS
        h = rmsnorm(x, norm_w[i])
        mem_h = rmsnorm(mem, mem_norm_w[i])
        if i % N_MIXERS == 0:
            proj = h @ s5_w_in[j]
            u, gate_mix, q_x, gate_x = jnp.split(
                proj, [TOKEN_WIDTH, 2 * TOKEN_WIDTH, 2 * TOKEN_WIDTH + XATTN_WIDTH], axis=-1)
            y_mix = s5_mixer(u, s5_lambda_re[j], s5_lambda_im[j], s5_log_step[j], s5_b_re[j],
                             s5_b_im[j], s5_c_re[j], s5_c_im[j], s5_d[j], s5_w_glu[j],
                             s5_b_glu[j]) * jax.nn.silu(gate_mix)
        else:
            proj = h @ gdn_w_in[j]
            o1 = 2 * GDN_QK_WIDTH + TOKEN_WIDTH
            o2 = o1 + GDN_V_HEADS
            o3 = o2 + GDN_V_HEADS
            o4 = o3 + TOKEN_WIDTH
            o5 = o4 + XATTN_WIDTH
            qkv, a, b, gate_mix, q_x, gate_x = jnp.split(proj, [o1, o2, o3, o4, o5], axis=-1)
            y_mix = gdn_mixer(qkv, a, b, gate_mix, gdn_conv_w[j], gdn_a_log[j], gdn_dt_bias[j],
                              gdn_norm_w[j])
        y_x = cross_attn(q_x, mem_h, w_mem_kv[i]) * jax.nn.silu(gate_x)
        x = x + jnp.concatenate([y_mix, y_x], axis=-1) @ w_out[i]
    return rmsnorm(x, final_norm_w)
```

```cpp
#include <hip/hip_runtime.h>
#include <hip/hip_cooperative_groups.h>
#include <cstdio>
namespace cg = cooperative_groups;

#define DUP_KIND -1
#define DBG_STOP 99
#define DUP_STEP -1
#ifndef MK_MULTI
#define MK_MULTI 0
#endif

typedef unsigned short u16;
typedef short bf16x8 __attribute__((ext_vector_type(8)));
typedef short s16x4 __attribute__((ext_vector_type(4)));
typedef float f32x2 __attribute__((ext_vector_type(2)));
typedef float f32x4 __attribute__((ext_vector_type(4)));
typedef float f32x16 __attribute__((ext_vector_type(16)));
typedef unsigned u32x2 __attribute__((ext_vector_type(2)));
typedef unsigned u32x4 __attribute__((ext_vector_type(4)));
typedef __bf16 bf16x2_t __attribute__((ext_vector_type(2)));
#define LAS __attribute__((address_space(3)))
#define DI __device__ __forceinline__

constexpr int T_ = 32768, D_ = 1024, SEQ = 8192;
constexpr int LDS5 = 4096, LDG = 5632, NGP = 5888;
constexpr int G_K0 = 768, G_V0 = 1536, G_QX = 3072, G_GM = 3584, G_GX = 5120;
constexpr size_t MiB = 1u << 20;
constexpr size_t WS_WIN = 0, WS_WGLU = 12 * MiB, WS_WOUT = 17 * MiB, WS_KMVT = 21 * MiB;
constexpr size_t WS_H = 29 * MiB;
constexpr size_t WS_GA = WS_H, WS_GC = WS_H + 48 * MiB;
constexpr size_t WS_PROJ = 93 * MiB;
constexpr size_t WS_MW = 445 * MiB, WS_AB = 493 * MiB, WS_HALO = 496 * MiB;
constexpr size_t WS_XLOC = WS_PROJ + 256 * MiB;
constexpr size_t WS_KT = 449 * MiB, WS_BC = 450 * MiB, WS_CC = 456 * MiB, WS_A16 = 462 * MiB;
constexpr size_t WS_WKV4 = WS_XLOC, WS_MEMH4 = WS_XLOC + 8 * MiB;
constexpr size_t WS_SST = 505 * MiB;
constexpr size_t WS_BAR = 508 * MiB;
constexpr size_t WS_SS = 508 * MiB + 65536;
constexpr size_t WS_SSP = 509 * MiB;
constexpr size_t WS_END = 511 * MiB;
constexpr int LDS_BYTES = 144 * 1024;

struct Params { const float* in[23]; float* out; unsigned char* ws; int ph_lo, ph_hi, dup_kind, dup_step, dbg, pad; };

DI unsigned pk2(float lo, float hi) { f32x2 v = {lo, hi}; bf16x2_t b = __builtin_convertvector(v, bf16x2_t); return __builtin_bit_cast(unsigned, b); }
DI u16 f2bf(float f) { return (u16)(pk2(f, 0.f) & 0xffffu); }
DI float bf2f(u16 b) { return __uint_as_float(((unsigned)b) << 16); }
DI float bflo(unsigned u) { return __uint_as_float(u << 16); }
DI float bfhi(unsigned u) { return __uint_as_float(u & 0xffff0000u); }
DI bf16x8 pack8(f32x4 a, f32x4 b) { u32x4 w; w.x = pk2(a[0], a[1]); w.y = pk2(a[2], a[3]); w.z = pk2(b[0], b[1]); w.w = pk2(b[2], b[3]); return __builtin_bit_cast(bf16x8, w); }
DI float wave_sum(float v) { for (int m = 32; m >= 1; m >>= 1) v += __shfl_xor(v, m); return v; }
DI float silu_f(float x) { return x * __builtin_amdgcn_rcpf(1.f + __expf(-x)); }
DI float sigmoid_f(float x) { return __builtin_amdgcn_rcpf(1.f + __expf(-x)); }
DI float gelu_tanh(float x) { float u = 0.7978845608028654f * (x + 0.044715f * x * x * x); float e = __expf(2.f * u); float th = 1.f - 2.f * __builtin_amdgcn_rcpf(e + 1.f); return 0.5f * x * (1.f + th); }
DI int crow(int reg, int h) { return (reg & 3) + 8 * (reg >> 2) + 4 * h; }
#define MFMA32(a, b, c) __builtin_amdgcn_mfma_f32_32x32x16_bf16((a), (b), (c), 0, 0, 0)
#define MFMA16(a, b, c) __builtin_amdgcn_mfma_f32_16x16x32_bf16((a), (b), (c), 0, 0, 0)
DI bf16x8 cat44(u32x2 lo, u32x2 hi) { u32x4 w = {lo.x, lo.y, hi.x, hi.y}; return __builtin_bit_cast(bf16x8, w); }
DI int opaque_tid() { int t = (int)threadIdx.x; asm volatile("" : "+v"(t)); return t; }
DI f32x16 zero16() { f32x16 z; for (int i = 0; i < 16; ++i) z[i] = 0.f; return z; }

namespace pg8 {
constexpr int BM = 256, BK = 64, HALF = 128, HTB = HALF * BK * 2, NXCD = 8, WGM = 8;
DI int lds_byte(int r, int c) { const int st = (r >> 4) * 2 + (c >> 5), rr = r & 15, cc = c & 31, ob = rr * 64 + cc * 2; return st * 1024 + (ob ^ (((ob >> 9) & 1) << 5)); }
DI void stage_rc(int b, int& R, int& C) { const int st = b / 1024, sb = b % 1024, swz = sb ^ (((sb >> 9) & 1) << 5); R = (st >> 1) * 16 + swz / 64; C = (st & 1) * 32 + (swz % 64) / 2; }
DI int perm32(int rho) { const int n = rho >> 4, i = rho & 15; return 8 * (i >> 2) + 4 * n + (i & 3); }
struct Unit { int pm, pn; };
struct Gemm { const u16* A; const u16* Bt; int M, N, K, lda; };
struct StaticOrder {
    int nM, nN, nwg, G, c;
    DI void init(int M, int N, int G_, int c_) { nM = M / BM; nN = N / BM; nwg = nM * nN; G = G_; c = c_; }
    DI bool next(int i, Unit& u) const {
        const long L = (long)i * G + c; if (L >= nwg) return false;
        int wgid = (int)L; { const int q = nwg / NXCD, r = nwg % NXCD, xcd = wgid % NXCD, off = wgid / NXCD; wgid = (xcd < r ? xcd * (q + 1) : r * (q + 1) + (xcd - r) * q) + off; }
        const int nig = WGM * nN, gid = wgid / nig, fm = gid * WGM, gsz = (nM - fm) < WGM ? (nM - fm) : WGM;
        u.pm = fm + ((wgid % nig) % gsz); u.pn = (wgid % nig) / gsz; return true;
    }
};

template <class Epi>
DI void gemm_phase(LAS unsigned char* lds, const Gemm g, const StaticOrder& S, const Epi& E) {
    const int tid = opaque_tid(), wid = __builtin_amdgcn_readfirstlane(tid >> 6), lane = tid & 63, wr = wid >> 2, wc = wid & 3, fr = lane & 15, fq = lane >> 4;
    const int K = g.K, nt = K / BK, lda = g.lda;
    unsigned voffA[2], voffB[2];
#pragma unroll
    for (int i = 0; i < 2; ++i) { int R, C; stage_rc(tid * 16 + i * 8192, R, C); const int Rb = Epi::PERM ? ((R & ~31) + perm32(R & 31)) : R;
        voffA[i] = (unsigned)(R * lda + C) * 2u; voffB[i] = (unsigned)(Rb * K + C) * 2u; }
    const size_t kstep = (size_t)(BK * 2);
    const size_t hstepA = (size_t)HALF * lda * 2, hstepB = (size_t)HALF * K * 2;
    const size_t tstepA = 2 * hstepA, tstepB = 2 * hstepB;
    const unsigned ldsw = (unsigned)wid * 1024u;
    const int aoff = lds_byte(wr * 64 + fr, fq * 8), boff = lds_byte(wc * 32 + fr, fq * 8);
#define PG8_SA(b, h) (((b) * 2 + (h)) * HTB)
#define PG8_SB(b, h) ((4 + (b) * 2 + (h)) * HTB)
#define PG8_STAGE(bufoff, gbase, voff) do { _Pragma("unroll") for (int _i = 0; _i < 2; ++_i) \
        __builtin_amdgcn_global_load_lds((const unsigned*)((const char*)(gbase) + (voff)[_i]), (LAS unsigned*)(lds + (bufoff) + ldsw + _i * 8192), 16, 0, 0); } while (0)
#define PG8_LDA(dst, b, h) do { _Pragma("unroll") for (int m = 0; m < 4; ++m) _Pragma("unroll") for (int k = 0; k < 2; ++k) dst[m][k] = *(const LAS bf16x8*)(lds + PG8_SA(b, h) + aoff + m * 2048 + k * 1024); } while (0)
#define PG8_LDB(dst, b, h) do { _Pragma("unroll") for (int n = 0; n < 2; ++n) _Pragma("unroll") for (int k = 0; k < 2; ++k) dst[n][k] = *(const LAS bf16x8*)(lds + PG8_SB(b, h) + boff + n * 2048 + k * 1024); } while (0)
#define PG8_MMA(ai, bj, At, Bt) do { __builtin_amdgcn_s_setprio(1); _Pragma("unroll") for (int m = 0; m < 4; ++m) _Pragma("unroll") for (int n = 0; n < 2; ++n) _Pragma("unroll") for (int k = 0; k < 2; ++k) \
        acc[ai][bj][m][n] = __builtin_amdgcn_mfma_f32_16x16x32_bf16(Bt[n][k], At[m][k], acc[ai][bj][m][n], 0, 0, 0); __builtin_amdgcn_s_setprio(0); } while (0)
#define PG8_WAIT_V(n) asm volatile("s_waitcnt vmcnt(" #n ")" ::: "memory")
#define PG8_WAIT_L(n) asm volatile("s_waitcnt lgkmcnt(" #n ")" ::: "memory")
#define PG8_BAR __builtin_amdgcn_s_barrier()
#define PG8_SCHED __builtin_amdgcn_sched_barrier(0)
    Unit cur, nxt; int ui = 0;
    if (!S.next(0, cur)) return;
    f32x4 acc[2][2][4][2];
#pragma unroll
    for (int a = 0; a < 2; ++a)
#pragma unroll
        for (int b = 0; b < 2; ++b)
#pragma unroll
            for (int m = 0; m < 4; ++m)
#pragma unroll
                for (int n = 0; n < 2; ++n) acc[a][b][m][n] = (f32x4){0.f, 0.f, 0.f, 0.f};
    bf16x8 At[4][2], B0[2][2], B1[2][2];
    const char* cA = (const char*)g.A + (size_t)cur.pm * tstepA; const char* cB = (const char*)g.Bt + (size_t)cur.pn * tstepB;
    PG8_STAGE(PG8_SB(0, 0), cB, voffB); PG8_STAGE(PG8_SB(0, 1), cB + hstepB, voffB); PG8_STAGE(PG8_SA(0, 0), cA, voffA); PG8_STAGE(PG8_SA(0, 1), cA + hstepA, voffA);
    if (wr == 1) PG8_BAR;
    PG8_WAIT_V(2); PG8_BAR;
    PG8_STAGE(PG8_SB(1, 0), cB + kstep, voffB); PG8_STAGE(PG8_SA(1, 0), cA + kstep, voffA); PG8_STAGE(PG8_SB(1, 1), cB + hstepB + kstep, voffB);
    PG8_WAIT_V(6); PG8_BAR;
    for (;;) {
        const bool has_next = S.next(ui + 1, nxt);
        const char* nA = has_next ? (const char*)g.A + (size_t)nxt.pm * tstepA : cA; const char* nB = has_next ? (const char*)g.Bt + (size_t)nxt.pn * tstepB : cB;
        for (int t = 0; t < nt; t += 2) {
            const bool last = (t == nt - 2);
            const char* a1 = cA + (size_t)(t + 1) * kstep;
            const char* a2 = last ? nA : cA + (size_t)(t + 2) * kstep; const char* b2 = last ? nB : cB + (size_t)(t + 2) * kstep;
            const char* a3 = a2 + kstep; const char* b3 = b2 + kstep;
            PG8_LDB(B0, 0, 0); PG8_LDB(B1, 0, 1); PG8_SCHED; PG8_LDA(At, 0, 0); PG8_STAGE(PG8_SA(1, 1), a1 + hstepA, voffA);
            PG8_WAIT_V(8); PG8_WAIT_L(0); PG8_BAR; PG8_MMA(0, 0, At, B0); PG8_MMA(0, 1, At, B1); PG8_BAR; PG8_SCHED;
            PG8_LDA(At, 0, 1); PG8_STAGE(PG8_SB(0, 0), b2, voffB); PG8_STAGE(PG8_SB(0, 1), b2 + hstepB, voffB); PG8_STAGE(PG8_SA(0, 0), a2, voffA);
            PG8_WAIT_V(8); PG8_WAIT_L(0); PG8_BAR; PG8_MMA(1, 0, At, B0); PG8_MMA(1, 1, At, B1); PG8_BAR; PG8_SCHED;
            PG8_LDB(B0, 1, 0); PG8_LDB(B1, 1, 1); PG8_SCHED; PG8_LDA(At, 1, 0); PG8_STAGE(PG8_SA(0, 1), a2 + hstepA, voffA);
            PG8_WAIT_V(8); PG8_WAIT_L(0); PG8_BAR; PG8_MMA(0, 0, At, B0); PG8_MMA(0, 1, At, B1); PG8_BAR; PG8_SCHED;
            PG8_LDA(At, 1, 1); PG8_STAGE(PG8_SB(1, 0), b3, voffB); PG8_STAGE(PG8_SB(1, 1), b3 + hstepB, voffB); PG8_STAGE(PG8_SA(1, 0), a3, voffA);
            PG8_WAIT_V(8); PG8_WAIT_L(0); PG8_BAR; PG8_MMA(1, 0, At, B0); PG8_MMA(1, 1, At, B1); PG8_BAR; PG8_SCHED;
        }
        if (wr == 0) PG8_BAR;
        E(acc, cur, wr, wc, fr, fq);
        if (!has_next) break;
#pragma unroll
        for (int a = 0; a < 2; ++a)
#pragma unroll
            for (int b = 0; b < 2; ++b)
#pragma unroll
                for (int m = 0; m < 4; ++m)
#pragma unroll
                    for (int n = 0; n < 2; ++n) acc[a][b][m][n] = (f32x4){0.f, 0.f, 0.f, 0.f};
        cur = nxt; cA = nA; cB = nB; ++ui;
        if (wr == 1) PG8_BAR;
    }
    PG8_WAIT_V(0);
    PG8_BAR;
#undef PG8_SA
#undef PG8_SB
#undef PG8_STAGE
#undef PG8_LDA
#undef PG8_LDB
#undef PG8_MMA
#undef PG8_WAIT_V
#undef PG8_WAIT_L
#undef PG8_BAR
#undef PG8_SCHED
}
}

#define EPI_LOOP_PERM(body) \
    _Pragma("unroll") for (int ai = 0; ai < 2; ++ai) _Pragma("unroll") for (int m = 0; m < 4; ++m) { const int row = u.pm * 256 + ai * 128 + wr * 64 + m * 16 + fr; \
    _Pragma("unroll") for (int bj = 0; bj < 2; ++bj) { const int col = u.pn * 256 + bj * 128 + wc * 32 + 8 * fq; f32x4 v0 = acc[ai][bj][m][0], v1 = acc[ai][bj][m][1]; body } }

struct EpiS5In {
    static constexpr bool PERM = true;
    u16* proj; const float* ss;
    DI void operator()(const f32x4 (&acc)[2][2][4][2], const pg8::Unit& u, int wr, int wc, int fr, int fq) const {
        const bool act = (u.pn >= 6 && u.pn < 12) || u.pn >= 14;
        float rsv[2][4];
#pragma unroll
        for (int ai = 0; ai < 2; ++ai)
#pragma unroll
            for (int m = 0; m < 4; ++m) rsv[ai][m] = ss[u.pm * 256 + ai * 128 + wr * 64 + m * 16 + fr];
#pragma unroll
        for (int ai = 0; ai < 2; ++ai)
#pragma unroll
            for (int m = 0; m < 4; ++m) rsv[ai][m] = rsqrtf(rsv[ai][m] * (1.f / 1024.f) + 1e-6f);
        EPI_LOOP_PERM(
            { const float rs = rsv[ai][m]; v0 *= rs; v1 *= rs; }
            if (act) { for (int j = 0; j < 4; ++j) { v0[j] = silu_f(v0[j]); v1[j] = silu_f(v1[j]); } }
            __builtin_nontemporal_store(__builtin_bit_cast(u32x4, pack8(v0, v1)), (u32x4*)(proj + (size_t)row * LDS5 + col));
        )
    }
};
struct EpiGdnIn {
    static constexpr bool PERM = true;
    u16* proj; float* ab; u16* halo; const float* ss;
    DI void operator()(const f32x4 (&acc)[2][2][4][2], const pg8::Unit& u, int wr, int wc, int fr, int fq) const {
        const int pn = u.pn;
        float rsv[2][4];
#pragma unroll
        for (int ai = 0; ai < 2; ++ai)
#pragma unroll
            for (int m = 0; m < 4; ++m) rsv[ai][m] = ss[u.pm * 256 + ai * 128 + wr * 64 + m * 16 + fr];
#pragma unroll
        for (int ai = 0; ai < 2; ++ai)
#pragma unroll
            for (int m = 0; m < 4; ++m) rsv[ai][m] = rsqrtf(rsv[ai][m] * (1.f / 1024.f) + 1e-6f);
        EPI_LOOP_PERM(
            { const float rs = rsv[ai][m]; v0 *= rs; v1 *= rs; }
            if (pn < 22) {
                if (pn >= 14) { for (int j = 0; j < 4; ++j) { v0[j] = silu_f(v0[j]); v1[j] = silu_f(v1[j]); } }
                const u32x4 w = __builtin_bit_cast(u32x4, pack8(v0, v1));
                __builtin_nontemporal_store(w, (u32x4*)(proj + (size_t)row * LDG + col));
                if (pn < 12 && (row & 63) >= 61) *(u32x4*)(halo + ((size_t)(row >> 6) * 3 + ((row & 63) - 61)) * 3072 + col) = w;
            } else {
                const int c = col - LDG;
                if (c < 24) { *(f32x4*)(ab + (size_t)row * 24 + c) = v0; *(f32x4*)(ab + (size_t)row * 24 + c + 4) = v1; }
            }
        )
    }
};
struct EpiKV {
    static constexpr bool PERM = true;
    u16* km; u16* vt;
    DI void operator()(const f32x4 (&acc)[2][2][4][2], const pg8::Unit& u, int wr, int wc, int fr, int fq) const {
        EPI_LOOP_PERM(
            if (col < 512) *(u32x4*)(km + (size_t)row * 512 + col) = __builtin_bit_cast(u32x4, pack8(v0, v1));
            else { for (int j = 0; j < 4; ++j) { vt[(size_t)(col - 512 + j) * 1024 + row] = f2bf(v0[j]); vt[(size_t)(col - 512 + 4 + j) * 1024 + row] = f2bf(v1[j]); } }
        )
    }
};
struct EpiGlu {
    static constexpr bool PERM = true;
    u16* proj; const float* bglu; bool dry;
    DI void operator()(const f32x4 (&acc)[2][2][4][2], const pg8::Unit& u, int wr, int wc, int fr, int fq) const {
        f32x4 bb[2][2];
#pragma unroll
        for (int bj = 0; bj < 2; ++bj) { const int col = u.pn * 256 + bj * 128 + wc * 32 + 8 * fq; bb[bj][0] = *(const f32x4*)(bglu + col); bb[bj][1] = *(const f32x4*)(bglu + col + 4); }
#pragma unroll
        for (int aim = 0; aim < 4; ++aim) { const int ai = aim >> 1, m0 = (aim & 1) * 2;
            u32x4 ygv[4][2], sgv[4][2];
#pragma unroll
            for (int m = m0; m < m0 + 2; ++m)
#pragma unroll
                for (int bj = 0; bj < 2; ++bj) { const u16* rp = proj + (size_t)(u.pm * 256 + ai * 128 + wr * 64 + m * 16 + fr) * LDS5 + u.pn * 256 + bj * 128 + wc * 32 + 8 * fq;
                    ygv[m][bj] = *(const u32x4*)rp; sgv[m][bj] = *(const u32x4*)(rp + 1536); }
#pragma unroll
            for (int m = m0; m < m0 + 2; ++m)
#pragma unroll
                for (int bj = 0; bj < 2; ++bj) { const f32x4 v0 = acc[ai][bj][m][0], v1 = acc[ai][bj][m][1], b0 = bb[bj][0], b1 = bb[bj][1]; const u32x4 yg = ygv[m][bj], sg = sgv[m][bj];
                    u16* gp = proj + (size_t)(u.pm * 256 + ai * 128 + wr * 64 + m * 16 + fr) * LDS5 + 1536 + u.pn * 256 + bj * 128 + wc * 32 + 8 * fq;
                    f32x4 o0; f32x4 o1;
                    o0[0] = bflo(yg.x) * sigmoid_f(v0[0] + b0[0]) * bflo(sg.x); o0[1] = bfhi(yg.x) * sigmoid_f(v0[1] + b0[1]) * bfhi(sg.x);
                    o0[2] = bflo(yg.y) * sigmoid_f(v0[2] + b0[2]) * bflo(sg.y); o0[3] = bfhi(yg.y) * sigmoid_f(v0[3] + b0[3]) * bfhi(sg.y);
                    o1[0] = bflo(yg.z) * sigmoid_f(v1[0] + b1[0]) * bflo(sg.z); o1[1] = bfhi(yg.z) * sigmoid_f(v1[1] + b1[1]) * bfhi(sg.z);
                    o1[2] = bflo(yg.w) * sigmoid_f(v1[2] + b1[2]) * bflo(sg.w); o1[3] = bfhi(yg.w) * sigmoid_f(v1[3] + b1[3]) * bfhi(sg.w);
                    if (!dry) *(u32x4*)gp = __builtin_bit_cast(u32x4, pack8(o0, o1)); }
        }
    }
};
struct EpiOut {
    static constexpr bool PERM = true;
    const float* xin; float* xout; bool dry; const float* wnext; u16* h; float* ssn;
    DI void operator()(const f32x4 (&acc)[2][2][4][2], const pg8::Unit& u, int wr, int wc, int fr, int fq) const {
        f32x4 wn[2][2];
#pragma unroll
        for (int bj = 0; bj < 2; ++bj)
#pragma unroll
            for (int n = 0; n < 2; ++n) wn[bj][n] = wnext ? *(const f32x4*)(wnext + u.pn * 256 + bj * 128 + wc * 32 + 8 * fq + 4 * n) : (f32x4){0.f, 0.f, 0.f, 0.f};
#pragma unroll
        for (int aim = 0; aim < 4; ++aim) { const int ai = aim >> 1, m0 = (aim & 1) * 2;
            f32x4 xi[4][2][2];
#pragma unroll
            for (int m = m0; m < m0 + 2; ++m)
#pragma unroll
                for (int bj = 0; bj < 2; ++bj)
#pragma unroll
                    for (int n = 0; n < 2; ++n) xi[m][bj][n] = *(const f32x4*)(xin + (size_t)(u.pm * 256 + ai * 128 + wr * 64 + m * 16 + fr) * D_ + u.pn * 256 + bj * 128 + wc * 32 + 8 * fq + 4 * n);
#pragma unroll
            for (int m = m0; m < m0 + 2; ++m) { const size_t row = (size_t)(u.pm * 256 + ai * 128 + wr * 64 + m * 16 + fr); float sq = 0.f;
#pragma unroll
                for (int bj = 0; bj < 2; ++bj) { const int col = u.pn * 256 + bj * 128 + wc * 32 + 8 * fq;
                    const f32x4 x0 = xi[m][bj][0] + acc[ai][bj][m][0], x1 = xi[m][bj][1] + acc[ai][bj][m][1];
                    sq += x0[0] * x0[0] + x0[1] * x0[1] + x0[2] * x0[2] + x0[3] * x0[3] + x1[0] * x1[0] + x1[1] * x1[1] + x1[2] * x1[2] + x1[3] * x1[3];
                    if (!dry) { __builtin_nontemporal_store(x0, (f32x4*)(xout + row * D_ + col)); __builtin_nontemporal_store(x1, (f32x4*)(xout + row * D_ + col + 4));
                        if (wnext) *(u32x4*)(h + row * D_ + col) = __builtin_bit_cast(u32x4, pack8(x0 * wn[bj][0], x1 * wn[bj][1])); } }
                sq += __shfl_xor(sq, 16); sq += __shfl_xor(sq, 32);
                if (fq == 0 && !dry) ssn[row * 16 + u.pn * 4 + wc] = sq; }
        }
    }
};

DI int gdn_map(int n) { if (n < 3072) return n; if (n < 3584) return n + 1560; if (n < 5120) return n - 488; if (n < 5632) return n + 24; if (n < 5656) return n - 2560; return -1; }
DI void transpose_w(const float* src, int Nsrc, u16* dst, int K, int Ndst, int mode, float* tl, int bid, int nblk) {
    const int nkt = K / 64, nnt = Ndst / 64, ntile = nkt * nnt, tid = opaque_tid();
    for (int tb = bid * 4; tb < ntile; tb += nblk * 4) {
        __syncthreads();
        float v[4][8];
#pragma unroll
        for (int u = 0; u < 4; ++u) { const int t = tb + u; const int kt = t % nkt, nt_ = t / nkt, k0 = kt * 64, n0 = nt_ * 64;
#pragma unroll
            for (int q = 0; q < 8; ++q) { const int e = tid + q * 512, kk = e >> 6, nn = e & 63; const int n = n0 + nn; const int sc = mode ? gdn_map(n) : n;
                v[u][q] = (t < ntile && sc >= 0) ? src[(size_t)(k0 + kk) * Nsrc + sc] : 0.f; } }
#pragma unroll
        for (int u = 0; u < 4; ++u)
#pragma unroll
            for (int q = 0; q < 8; ++q) { const int e = tid + q * 512, kk = e >> 6, nn = e & 63; tl[u * 4160 + nn * 65 + kk] = v[u][q]; }
        __syncthreads();
#pragma unroll
        for (int u = 0; u < 4; ++u) { const int t = tb + u; if (t < ntile) { const int kt = t % nkt, nt_ = t / nkt, k0 = kt * 64, n0 = nt_ * 64;
#pragma unroll
            for (int q = 0; q < 4; ++q) { const int e = tid + q * 512, nn = e >> 5, kk = (e & 31) * 2;
                *(unsigned*)(dst + (size_t)(n0 + nn) * K + k0 + kk) = pk2(tl[u * 4160 + nn * 65 + kk], tl[u * 4160 + nn * 65 + kk + 1]); } } }
    }
}
DI void norm_rows_bf16(const float* x, const float* w, u16* h, int nrows, int bid, int nblk) {
    const int tidw_ = opaque_tid(); const int wave = __builtin_amdgcn_readfirstlane(tidw_ >> 6), lane = tidw_ & 63;
    for (int r = bid * 8 + wave; r < nrows; r += nblk * 8) {
        const f32x4* xr = (const f32x4*)(x + (size_t)r * 1024);
        f32x4 v[4]; float ss = 0.f;
#pragma unroll
        for (int i = 0; i < 4; ++i) { v[i] = xr[lane + 64 * i]; ss += v[i][0] * v[i][0] + v[i][1] * v[i][1] + v[i][2] * v[i][2] + v[i][3] * v[i][3]; }
        ss = wave_sum(ss);
        const float rs = rsqrtf(ss * (1.f / 1024.f) + 1e-6f);
#pragma unroll
        for (int i = 0; i < 4; ++i) { const f32x4 w4 = ((const f32x4*)w)[lane + 64 * i]; u32x2 o; o.x = pk2(v[i][0] * rs * w4[0], v[i][1] * rs * w4[1]); o.y = pk2(v[i][2] * rs * w4[2], v[i][3] * rs * w4[3]);
            *(u32x2*)(h + (size_t)r * 1024 + (lane + 64 * i) * 4) = o; }
    }
}
DI void prep_rows(const float* x, const float* w, u16* h, float* ss, int bid, int nblk) {
    const int tidw_ = opaque_tid(); const int wave = __builtin_amdgcn_readfirstlane(tidw_ >> 6), lane = tidw_ & 63;
    const int stride = nblk * 8;
    f32x4 w4[4];
#pragma unroll
    for (int i = 0; i < 4; ++i) w4[i] = ((const f32x4*)w)[lane + 64 * i];
    for (int r = bid * 8 + wave; r < T_; r += 4 * stride) {
        f32x4 v[4][4];
#pragma unroll
        for (int k = 0; k < 4; ++k) { const int rr = r + k * stride < T_ ? r + k * stride : r;
#pragma unroll
            for (int i = 0; i < 4; ++i) v[k][i] = ((const f32x4*)(x + (size_t)rr * 1024))[lane + 64 * i]; }
#pragma unroll
        for (int k = 0; k < 4; ++k) { const int rr = r + k * stride; if (rr >= T_) break; float sq = 0.f;
#pragma unroll
            for (int i = 0; i < 4; ++i) sq += v[k][i][0] * v[k][i][0] + v[k][i][1] * v[k][i][1] + v[k][i][2] * v[k][i][2] + v[k][i][3] * v[k][i][3];
            sq = wave_sum(sq);
            if (lane == 0) ss[rr] = sq;
#pragma unroll
            for (int i = 0; i < 4; ++i) { u32x2 o; o.x = pk2(v[k][i][0] * w4[i][0], v[k][i][1] * w4[i][1]); o.y = pk2(v[k][i][2] * w4[i][2], v[k][i][3] * w4[i][3]);
                *(u32x2*)(h + (size_t)rr * 1024 + (lane + 64 * i) * 4) = o; } }
    }
}
DI void final_norm(float* x, const float* w, const float* ss, int bid, int nblk) {
    const int tidw_ = opaque_tid(); const int wave = __builtin_amdgcn_readfirstlane(tidw_ >> 6), lane = tidw_ & 63;
    const int stride = nblk * 8;
    f32x4 w4[4];
#pragma unroll
    for (int i = 0; i < 4; ++i) w4[i] = ((const f32x4*)w)[lane + 64 * i];
    for (int r = bid * 8 + wave; r < T_; r += 4 * stride) {
        f32x4 v[4][4]; float sq[4];
#pragma unroll
        for (int k = 0; k < 4; ++k) { const int rr = r + k * stride < T_ ? r + k * stride : r;
#pragma unroll
            for (int i = 0; i < 4; ++i) v[k][i] = ((const f32x4*)(x + (size_t)rr * 1024))[lane + 64 * i];
            sq[k] = lane < 16 ? ss[(size_t)rr * 16 + lane] : 0.f; }
#pragma unroll
        for (int k = 0; k < 4; ++k) { const int rr = r + k * stride; if (rr >= T_) break;
            const float rs = rsqrtf(wave_sum(sq[k]) * (1.f / 1024.f) + 1e-6f);
#pragma unroll
            for (int i = 0; i < 4; ++i) ((f32x4*)(x + (size_t)rr * 1024))[lane + 64 * i] = v[k][i] * rs * w4[i]; }
    }
}
DI void s5_tables(const Params& p, int j, float* sm, int bid, int nblk) {
    float* ap_re = sm; float* ap_im = ap_re + 17 * 64; float* bb_re = ap_im + 17 * 64; float* bb_im = bb_re + 1024; float* c_re = bb_im + 1024; float* c_im = c_re + 1024;
    u16* Kt = (u16*)(p.ws + WS_KT); u16* Bc = (u16*)(p.ws + WS_BC); u16* Cc = (u16*)(p.ws + WS_CC); float* a16 = (float*)(p.ws + WS_A16);
    const int tid = opaque_tid();
    for (int g = bid; g < 96; g += nblk) {
        __syncthreads();
        const int gg = j * 96 + g;
        if (tid < 64) {
            const float dt = expf(p.in[9][gg]);
            const float lr = p.in[7][gg * 64 + tid], li = p.in[8][gg * 64 + tid];
            const float mag = expf(lr * dt); float sn, cs; sincosf(li * dt, &sn, &cs);
            const float ar = mag * cs, ai = mag * sn;
            const float den = lr * lr + li * li, nr = ar - 1.f, ni = ai;
            const float cr = (nr * lr + ni * li) / den, ci = (ni * lr - nr * li) / den;
            float pr = 1.f, pi = 0.f;
            for (int q = 0; q <= 16; ++q) { ap_re[q * 64 + tid] = pr; ap_im[q * 64 + tid] = pi; const float t = pr * ar - pi * ai; pi = pr * ai + pi * ar; pr = t; }
            for (int h = 0; h < 16; ++h) { const float br = p.in[10][((size_t)gg * 64 + tid) * 16 + h], bi = p.in[11][((size_t)gg * 64 + tid) * 16 + h];
                bb_re[tid * 16 + h] = cr * br - ci * bi; bb_im[tid * 16 + h] = cr * bi + ci * br; }
        }
        for (int e = tid; e < 1024; e += 512) { c_re[e] = p.in[12][(size_t)gg * 1024 + e]; c_im[e] = p.in[13][(size_t)gg * 1024 + e]; }
        __syncthreads();
        for (int e = tid; e < 4096; e += 512) { const int lag = e >> 8, h = (e >> 4) & 15, h2 = e & 15; float s = 0.f;
            for (int pp = 0; pp < 64; ++pp) { const float cr_ = c_re[h * 64 + pp], ci_ = c_im[h * 64 + pp], ar_ = ap_re[lag * 64 + pp], ai_ = ap_im[lag * 64 + pp];
                const float mr = cr_ * ar_ - ci_ * ai_, mi = cr_ * ai_ + ci_ * ar_; s += mr * bb_re[pp * 16 + h2] - mi * bb_im[pp * 16 + h2]; }
            if (lag == 0 && h == h2) s += p.in[14][j * 1536 + g * 16 + h];
            Kt[(size_t)g * 4096 + e] = f2bf(s); }
        for (int e = tid; e < 32768; e += 512) { const int n = e >> 8, k = e & 255, s_ = k >> 4, h2 = k & 15, pp = n & 63, q = 15 - s_;
            const float ar_ = ap_re[q * 64 + pp], ai_ = ap_im[q * 64 + pp], br_ = bb_re[pp * 16 + h2], bi_ = bb_im[pp * 16 + h2];
            Bc[(size_t)g * 32768 + e] = f2bf(n < 64 ? ar_ * br_ - ai_ * bi_ : ar_ * bi_ + ai_ * br_); }
        for (int e = tid; e < 32768; e += 512) { const int n = e >> 7, k = e & 127, s_ = n >> 4, h = n & 15, pp = k & 63, q = s_ + 1;
            const float cr_ = c_re[h * 64 + pp], ci_ = c_im[h * 64 + pp], ar_ = ap_re[q * 64 + pp], ai_ = ap_im[q * 64 + pp];
            const float mr = cr_ * ar_ - ci_ * ai_, mi = cr_ * ai_ + ci_ * ar_;
            Cc[(size_t)g * 32768 + e] = f2bf(k < 64 ? mr : -mi); }
        if (tid < 64) { a16[(g * 64 + tid) * 2] = ap_re[16 * 64 + tid]; a16[(g * 64 + tid) * 2 + 1] = ap_im[16 * 64 + tid]; }
    }
}

DI bool s5_task(int it, int bid, int nblk, int& g, int& mb) {
    if (nblk == 256) { const int xcd = bid & 7, slot = bid >> 3; const int qt = (it * 8 + (slot >> 2)) * 8 + xcd; if (qt >= 192) return false; g = (qt % 24) * 4 + (slot & 3); mb = qt / 24; return true; }
    const int t = it * nblk + bid; if (t >= 768) return false; g = t % 96; mb = t / 96; return true;
}
DI void s5a_phase(const Params& p, unsigned char* smem, int bid, int nblk) {
    const u16* proj = (const u16*)(p.ws + WS_PROJ); const u16* Bc = (const u16*)(p.ws + WS_BC); float* Xloc = (float*)(p.ws + WS_XLOC);
    u16* TB = (u16*)smem;
    const int tid = opaque_tid(), wave = __builtin_amdgcn_readfirstlane(tid >> 6), lane = tid & 63, r = lane & 31, h = lane >> 5;
    int g, mb;
    for (int it = 0; s5_task(it, bid, nblk, g, mb); ++it) {
        const int chunk0 = mb * 256 + wave * 32;
        u32x4 tb[8];
#pragma unroll
        for (int q = 0; q < 8; ++q) tb[q] = *(const u32x4*)(Bc + (unsigned)(g * 32768 + (tid + q * 512) * 8));
        bf16x8 a[16];
        const u16* up = proj + (unsigned)(((chunk0 + r) * 16) * LDS5 + g * 16 + 8 * h);
#pragma unroll
        for (int s = 0; s < 16; ++s) a[s] = *(const bf16x8*)(up + (unsigned)(s * LDS5));
        __syncthreads();
#pragma unroll
        for (int q = 0; q < 8; ++q) { const int e = tid + q * 512, n = e >> 5, ch = e & 31; *(u32x4*)(TB + n * 264 + ch * 8) = tb[q]; }
        __syncthreads();
#pragma unroll
        for (int nt = 0; nt < 4; ++nt) { f32x16 acc = zero16(); const u16* bp = TB + (nt * 32 + r) * 264 + 8 * h; bf16x8 bv[16];
#pragma unroll
            for (int s = 0; s < 16; ++s) bv[s] = *(const bf16x8*)(bp + s * 16);
            __builtin_amdgcn_sched_barrier(0);
#pragma unroll
            for (int s = 0; s < 16; ++s) acc = MFMA32(a[s], bv[s], acc);
#pragma unroll
            for (int i = 0; i < 16; ++i) Xloc[(unsigned)(((chunk0 + crow(i, h)) * 96 + g) * 128 + nt * 32 + r)] = acc[i]; }
    }
}
DI void s5b_phase(const Params& p, float* sm, int bid, int nblk, bool dry) {
    float* Xloc = (float*)(p.ws + WS_XLOC); const float* a16 = (const float*)(p.ws + WS_A16);
    const int tid = opaque_tid(), pl = tid & 31, seg = tid >> 5;
    for (int item = bid; item < 768; item += nblk) {
        const int ph = item & 1, g = (item >> 1) % 96, b = item / 192; const int pp = ph * 32 + pl;
        const float ar = a16[(g * 64 + pp) * 2], ai = a16[(g * 64 + pp) * 2 + 1];
        float* base = Xloc + ((size_t)(b * 512 + seg * 32) * 96 + g) * 128 + pp;
        float yr[32], yi[32];
#pragma unroll
        for (int k = 0; k < 32; ++k) { yr[k] = base[(size_t)k * 12288]; yi[k] = base[(size_t)k * 12288 + 64]; }
#pragma unroll
        for (int k = 1; k < 32; ++k) { const float t = ar * yr[k - 1] - ai * yi[k - 1] + yr[k]; yi[k] = ar * yi[k - 1] + ai * yr[k - 1] + yi[k]; yr[k] = t; }
        float Ar = ar, Ai = ai;
#pragma unroll
        for (int q = 0; q < 5; ++q) { const float t = Ar * Ar - Ai * Ai; Ai = 2.f * Ar * Ai; Ar = t; }
        __syncthreads();
        sm[seg * 32 + pl] = yr[31]; sm[512 + seg * 32 + pl] = yi[31];
        __syncthreads();
        float cr = 0.f, ci = 0.f;
        for (int s2 = 0; s2 < seg; ++s2) { const float t = Ar * cr - Ai * ci + sm[s2 * 32 + pl]; ci = Ar * ci + Ai * cr + sm[512 + s2 * 32 + pl]; cr = t; }
        float pwr = 1.f, pwi = 0.f, prevr = 0.f, previ = 0.f;
#pragma unroll
        for (int k = 0; k < 32; ++k) { const float outr = prevr + pwr * cr - pwi * ci, outi = previ + pwr * ci + pwi * cr; prevr = yr[k]; previ = yi[k];
            if (!dry) { base[(size_t)k * 12288] = outr; base[(size_t)k * 12288 + 64] = outi; } const float t = pwr * ar - pwi * ai; pwi = pwr * ai + pwi * ar; pwr = t; }
    }
}
DI void s5c_phase(const Params& p, unsigned char* smem, int bid, int nblk, bool dry) {
    u16* proj = (u16*)(p.ws + WS_PROJ); const u16* Kt = (const u16*)(p.ws + WS_KT); const u16* Cc = (const u16*)(p.ws + WS_CC); const float* Xloc = (const float*)(p.ws + WS_XLOC);
    u16* TC = (u16*)smem; u16* TK = TC + 256 * 136;
    const int tid = opaque_tid(), wave = __builtin_amdgcn_readfirstlane(tid >> 6), lane = tid & 63, r = lane & 31, h = lane >> 5;
    int g, mb;
    for (int it = 0; s5_task(it, bid, nblk, g, mb); ++it) {
        const int chunk0 = mb * 256 + wave * 32;
        u32x4 tb[8];
#pragma unroll
        for (int q = 0; q < 8; ++q) tb[q] = *(const u32x4*)(Cc + (unsigned)(g * 32768 + (tid + q * 512) * 8));
        const u32x4 tk = *(const u32x4*)(Kt + (unsigned)(g * 4096 + tid * 8));
        bf16x8 a[16], xa[8];
        const u16* up = proj + (unsigned)(((chunk0 + r) * 16) * LDS5 + g * 16 + 8 * h);
#pragma unroll
        for (int s = 0; s < 16; ++s) a[s] = *(const bf16x8*)(up + (unsigned)(s * LDS5));
        const float* xp = Xloc + (unsigned)(((chunk0 + r) * 96 + g) * 128 + 8 * h);
#pragma unroll
        for (int s = 0; s < 8; ++s) xa[s] = pack8(*(const f32x4*)(xp + s * 16), *(const f32x4*)(xp + s * 16 + 4));
        __syncthreads();
#pragma unroll
        for (int q = 0; q < 8; ++q) { const int e = tid + q * 512, n = e >> 4, ch = e & 15; *(u32x4*)(TC + n * 136 + ch * 8) = tb[q]; }
        *(u32x4*)(TK + tid * 8) = tk;
        __syncthreads();
        const int ho = r & 15;
#pragma unroll
        for (int nt = 0; nt < 8; ++nt) { f32x16 acc = zero16(); const int so = 2 * nt + (r >> 4);
#pragma unroll
            for (int s = 0; s < 16; ++s) if (s <= 2 * nt + 1) { const int lag = so - s; bf16x8 bfr = *(const bf16x8*)(TK + (lag < 0 ? 0 : lag) * 256 + ho * 16 + 8 * h);
                if (lag < 0) bfr = (bf16x8){0, 0, 0, 0, 0, 0, 0, 0};
                acc = MFMA32(a[s], bfr, acc); }
            const u16* cp = TC + (nt * 32 + r) * 136 + 8 * h; bf16x8 cv[8];
#pragma unroll
            for (int s = 0; s < 8; ++s) cv[s] = *(const bf16x8*)(cp + s * 16);
            __builtin_amdgcn_sched_barrier(0);
#pragma unroll
            for (int s = 0; s < 8; ++s) acc = MFMA32(xa[s], cv[s], acc);
#pragma unroll
            for (int i = 0; i < 16; ++i) { const u16 val = f2bf(gelu_tanh(acc[i])); if (!dry) proj[(unsigned)(((chunk0 + crow(i, h)) * 16 + so) * LDS5 + g * 16 + ho)] = val; } }
    }
}

DI void xattn_phase(const Params& p, int layer, int ldp, int qx_col, int gx_col, unsigned char* smem, int bid, int nblk, bool dry) {
    u16* proj = (u16*)(p.ws + WS_PROJ); const u16* Km = (const u16*)(p.ws + WS_KMVT + (size_t)layer * 2 * MiB); const u16* VT = Km + 512 * 1024;
    u16* Ki = (u16*)smem; u16* Vi = Ki + 256 * 136;
    const int tid = opaque_tid(), wave = __builtin_amdgcn_readfirstlane(tid >> 6), lane = tid & 63, r = lane & 31, h = lane >> 5;
    int cur_bh = -1;
    for (int it = bid; it < 512; it += nblk) {
        const int bh = nblk == 256 ? (it & 255) >> 4 : it >> 5, qb = nblk == 256 ? (((it & 15) << 1) | (it >> 8)) : (it & 31), b = bh >> 2, hd = bh & 3;
        if (bh != cur_bh) {
            __syncthreads();
            u32x4 kq[8], vq[8];
#pragma unroll
            for (int q = 0; q < 8; ++q) { const int e = tid + q * 512; kq[q] = *(const u32x4*)(Km + (unsigned)((b * 256 + (e >> 4)) * 512 + hd * 128 + (e & 15) * 8)); vq[q] = *(const u32x4*)(VT + (unsigned)((hd * 128 + (e >> 5)) * 1024 + b * 256 + (e & 31) * 8)); }
#pragma unroll
            for (int q = 0; q < 8; ++q) { const int e = tid + q * 512; *(u32x4*)(Ki + (e >> 4) * 136 + (e & 15) * 8) = kq[q]; *(u32x4*)(Vi + (e >> 5) * 264 + (e & 31) * 8) = vq[q]; }
            __syncthreads(); cur_bh = bh;
        }
        const int q0 = b * SEQ + qb * 256 + wave * 32;
        u16* rowp = proj + (size_t)(q0 + r) * ldp;
        bf16x8 qf[8];
#pragma unroll
        for (int s = 0; s < 8; ++s) qf[s] = *(const bf16x8*)(rowp + qx_col + hd * 128 + s * 16 + 8 * h);
        f32x16 sacc[8];
#pragma unroll
        for (int kt = 0; kt < 8; ++kt) { f32x16 acc = zero16(); bf16x8 kfv[8];
#pragma unroll
            for (int s = 0; s < 8; ++s) kfv[s] = *(const bf16x8*)(Ki + (kt * 32 + r) * 136 + s * 16 + 8 * h);
            __builtin_amdgcn_sched_barrier(0);
#pragma unroll
            for (int s = 0; s < 8; ++s) acc = MFMA32(kfv[s], qf[s], acc);
            sacc[kt] = acc; }
        float mx = -3.0e38f;
#pragma unroll
        for (int kt = 0; kt < 8; ++kt)
#pragma unroll
            for (int i = 0; i < 16; ++i) mx = fmaxf(mx, sacc[kt][i]);
        mx = fmaxf(mx, __shfl_xor(mx, 32));
        const float sc = 0.08838834764831845f * 1.4426950408889634f;
        float sum = 0.f;
        bf16x8 pf[16];
#pragma unroll
        for (int kt = 0; kt < 8; ++kt) {
            f32x4 e4[4];
#pragma unroll
            for (int i = 0; i < 16; ++i) { const float pv = exp2f((sacc[kt][i] - mx) * sc); sum += pv; e4[i >> 2][i & 3] = pv; }
            pf[kt * 2] = pack8(e4[0], e4[1]); pf[kt * 2 + 1] = pack8(e4[2], e4[3]);
        }
        sum += __shfl_xor(sum, 32);
        const float inv = 1.f / sum;
        u32x2 gtv[4][4];
#pragma unroll
        for (int dt = 0; dt < 4; ++dt)
#pragma unroll
            for (int g4 = 0; g4 < 4; ++g4) gtv[dt][g4] = *(const u32x2*)(rowp + gx_col + hd * 128 + dt * 32 + 8 * g4 + 4 * h);
#pragma unroll
        for (int dt = 0; dt < 4; ++dt) { f32x16 acc = zero16();
            const u16* vrow = Vi + (dt * 32 + r) * 264 + 4 * h;
            bf16x8 vfv[16];
#pragma unroll
            for (int ks = 0; ks < 16; ++ks) vfv[ks] = cat44(*(const u32x2*)(vrow + ks * 16), *(const u32x2*)(vrow + ks * 16 + 8));
            __builtin_amdgcn_sched_barrier(0);
#pragma unroll
            for (int ks = 0; ks < 16; ++ks) acc = MFMA32(vfv[ks], pf[ks], acc);
#pragma unroll
            for (int g4 = 0; g4 < 4; ++g4) { const int d = hd * 128 + dt * 32 + 8 * g4 + 4 * h;
                const u32x2 gt = gtv[dt][g4];
                u32x2 o; o.x = pk2(acc[4 * g4] * inv * bflo(gt.x), acc[4 * g4 + 1] * inv * bfhi(gt.x)); o.y = pk2(acc[4 * g4 + 2] * inv * bflo(gt.y), acc[4 * g4 + 3] * inv * bfhi(gt.y));
                if (!dry) *(u32x2*)(rowp + qx_col + d) = o; } }
    }
}

DI void gd1_phase(const Params& p, int jl, unsigned char* smem, int bid, int nblk, int c_lo, int c_n, bool dry) {
    u16* proj = (u16*)(p.ws + WS_PROJ); const float* ab = (const float*)(p.ws + WS_AB); const u16* halo = (const u16*)(p.ws + WS_HALO);
    u16* Abuf = (u16*)(p.ws + WS_GA); u16* Mw = (u16*)(p.ws + WS_MW); float* gcG = (float*)(p.ws + WS_GC);
    const float* convw = p.in[18] + (size_t)jl * 4 * 3072; const float* a_log = p.in[19] + jl * 12; const float* dt_bias = p.in[20] + jl * 12;
    u16* qI = (u16*)smem; u16* kI = qI + 64 * 136; u16* vI = kI + 64 * 136;
    float* KK = (float*)(vI + 2 * 64 * 136); u16* Tbf = (u16*)KK;
    float* QK = KK + 64 * 65; float* Ls = QK + 64 * 65;
    float* gcS = Ls + 2 * 4096; float* btS = gcS + 128; float* bgS = btS + 128;
    const int tid = opaque_tid(), wave = __builtin_amdgcn_readfirstlane(tid >> 6), lane = tid & 63;
    for (int item = bid; item < 24 * c_n; item += nblk) {
        const int hq = item % 6, t_ = item / 6, cin = c_lo + t_ % c_n, gchunk = (t_ / c_n) * 128 + cin; const int t0 = gchunk * 64;
        __syncthreads();
        unsigned rawv[4][11]; f32x2 wv[4][4]; float betav[2][8]; float av_ = 0.f, bv_ = 0.f;
#pragma unroll
        for (int x = 0; x < 4; ++x) { const int cb = (x == 0 ? hq * 128 : x == 1 ? G_K0 + hq * 128 : G_V0 + (2 * hq + (x - 2)) * 128) + 2 * lane;
#pragma unroll
            for (int q = 0; q < 11; ++q) { const int rr = wave * 8 - 3 + q; unsigned raw = 0u;
                if (rr >= 0) raw = *(const unsigned*)(proj + (unsigned)((t0 + rr) * LDG + cb));
                else if (cin > 0) raw = *(const unsigned*)(halo + (unsigned)(((gchunk - 1) * 3 + (rr + 3)) * 3072 + cb));
                rawv[x][q] = raw; }
#pragma unroll
            for (int j = 0; j < 4; ++j) wv[x][j] = *(const f32x2*)(convw + j * 3072 + cb); }
#pragma unroll
        for (int e = 0; e < 2; ++e)
#pragma unroll
            for (int i = 0; i < 8; ++i) betav[e][i] = ab[(unsigned)((t0 + wave * 8 + i) * 24 + 12 + 2 * hq + e)];
        if (tid < 128) { const int e = tid >> 6, i = tid & 63; av_ = ab[(unsigned)((t0 + i) * 24 + 2 * hq + e)]; bv_ = ab[(unsigned)((t0 + i) * 24 + 12 + 2 * hq + e)]; }
#pragma unroll
        for (int x = 0; x < 4; ++x) {
            float res[8][2];
            float r0[11], r1[11];
#pragma unroll
            for (int q = 0; q < 11; ++q) { r0[q] = bflo(rawv[x][q]); r1[q] = bfhi(rawv[x][q]); }
#pragma unroll
            for (int i = 0; i < 8; ++i) { float s0 = 0.f, s1 = 0.f;
#pragma unroll
                for (int j = 0; j < 4; ++j) { s0 += r0[i + j] * wv[x][j][0]; s1 += r1[i + j] * wv[x][j][1]; }
                res[i][0] = silu_f(s0); res[i][1] = silu_f(s1); }
            if (x < 2) {
#pragma unroll
                for (int i = 0; i < 8; ++i) { const float ss = wave_sum(res[i][0] * res[i][0] + res[i][1] * res[i][1]);
                    const float rs = rsqrtf(ss + 1e-6f) * (x == 0 ? 0.08838834764831845f : 1.f); res[i][0] *= rs; res[i][1] *= rs; }
            }
            if (x >= 2) {
#pragma unroll
                for (int i = 0; i < 8; ++i) { const float beta = sigmoid_f(betav[x - 2][i]); res[i][0] *= beta; res[i][1] *= beta; }
            }
            u16* dstI = x == 0 ? qI : x == 1 ? kI : x == 2 ? vI : vI + 64 * 136; const int dstride = 136;
#pragma unroll
            for (int i = 0; i < 8; ++i) *(unsigned*)(dstI + (wave * 8 + i) * dstride + 2 * lane) = pk2(res[i][0], res[i][1]);
        }
        if (tid < 128) { const int e = tid >> 6, i = tid & 63, hv = 2 * hq + e;
            const float av = av_, bv = bv_;
            const float xs = av + dt_bias[hv]; const float sp = xs > 20.f ? xs : __logf(1.f + __expf(xs));
            float gv = -expf(a_log[hv]) * sp;
#pragma unroll
            for (int d = 1; d < 64; d <<= 1) { const float o = __shfl_up(gv, d); if (i >= d) gv += o; }
            const float beta = sigmoid_f(bv);
            gcS[e * 64 + i] = gv; btS[e * 64 + i] = beta; bgS[e * 64 + i] = beta * expf(gv);
            if (!dry) gcG[((size_t)gchunk * 12 + hv) * 64 + i] = gv; }
        __syncthreads();
        const int stop_ = dry ? p.dbg : 99;
        if (stop_ == 1) continue;
#pragma unroll
        for (int q = 0; q < 2; ++q) { const int e = tid + q * 512, row = e >> 4, ch = e & 15;
            const u32x4 qv_ = *(const u32x4*)(qI + row * 136 + ch * 8), kv_ = *(const u32x4*)(kI + row * 136 + ch * 8);
            if (!dry) { *(u32x4*)(proj + (size_t)(t0 + row) * LDG + hq * 128 + ch * 8) = qv_; *(u32x4*)(proj + (size_t)(t0 + row) * LDG + G_K0 + hq * 128 + ch * 8) = kv_; } }
        { const int r = lane & 31, h = lane >> 5, ti = (wave >> 1) & 1, tj = wave & 1; const u16* XI = (wave >> 2) ? qI : kI; f32x16 acc = zero16();
#pragma unroll
            for (int s = 0; s < 8; ++s) { const bf16x8 af = *(const bf16x8*)(XI + (32 * ti + r) * 136 + 16 * s + 8 * h), bfr = *(const bf16x8*)(kI + (32 * tj + r) * 136 + 16 * s + 8 * h); acc = MFMA32(af, bfr, acc); }
            float* M = (wave >> 2) ? QK : KK;
#pragma unroll
            for (int i = 0; i < 16; ++i) M[(32 * ti + crow(i, h)) * 65 + 32 * tj + r] = acc[i]; }
        __syncthreads();
        if (stop_ == 2) continue;
#pragma unroll
        for (int e = 0; e < 2; ++e) { const int hv = 2 * hq + e;
            for (int idx = tid; idx < 4096; idx += 512) { const int i = idx >> 6, j = idx & 63;
                const float dec = (i >= j) ? expf(gcS[e * 64 + i] - gcS[e * 64 + j]) : 0.f;
                Ls[e * 4096 + idx] = (i > j) ? btS[e * 64 + i] * KK[i * 65 + j] * dec : 0.f;
                const u16 av_ = f2bf(QK[i * 65 + j] * dec); if (!dry) Abuf[((size_t)gchunk * 12 + hv) * 4096 + idx] = av_; } }
        __syncthreads();
        if (stop_ == 3) continue;
        if (tid < 128) { const int e = tid >> 6, c = tid & 63, hv = 2 * hq + e; const float* Lr = Ls + e * 4096;
            float x[64];
#pragma unroll
            for (int i = 0; i < 64; ++i) { float acc = (i == c) ? 1.f : 0.f;
                float p0 = 0.f, p1 = 0.f, p2 = 0.f, p3 = 0.f;
#pragma unroll
                for (int j = 0; j < i; ++j) { const float t_ = Lr[i * 64 + j] * x[j]; if ((j & 3) == 0) p0 += t_; else if ((j & 3) == 1) p1 += t_; else if ((j & 3) == 2) p2 += t_; else p3 += t_; }
                acc -= (p0 + p1) + (p2 + p3);
                asm volatile("" : "+v"(acc) :: "memory"); x[i] = acc; }
            const float sc = bgS[e * 64 + c];
#pragma unroll
            for (int i = 0; i < 64; ++i) { Tbf[e * 4608 + i * 72 + c] = f2bf(x[i]); const u16 v_ = f2bf(x[i] * sc); if (!dry) Mw[((size_t)gchunk * 12 + hv) * 4096 + i * 64 + c] = v_; }
        }
        __syncthreads();
        { const int r = lane & 31, h = lane >> 5, e = wave >> 2, nd = wave & 3, hv = 2 * hq + e; const int li = lane & 15, rsub = (lane >> 4) & 1;
            f32x16 u0 = zero16(), u1 = zero16();
#pragma unroll
            for (int ks = 0; ks < 4; ++ks) { const u16* bp = vI + e * (64 * 136) + (16 * ks + 8 * h + (li >> 2)) * 136 + 32 * nd + 16 * rsub + 4 * (li & 3);
                const s16x4 lo = __builtin_amdgcn_ds_read_tr16_b64_v4i16((LAS s16x4*)(LAS u16*)bp), hi = __builtin_amdgcn_ds_read_tr16_b64_v4i16((LAS s16x4*)(LAS u16*)(bp + 4 * 136));
                const bf16x8 bfr = __builtin_shufflevector(lo, hi, 0, 1, 2, 3, 4, 5, 6, 7);
                const bf16x8 a0 = *(const bf16x8*)(Tbf + e * 4608 + r * 72 + 16 * ks + 8 * h), a1 = *(const bf16x8*)(Tbf + e * 4608 + (32 + r) * 72 + 16 * ks + 8 * h);
                u0 = MFMA32(a0, bfr, u0); u1 = MFMA32(a1, bfr, u1); }
            u16* up = proj + (size_t)t0 * LDG + G_V0 + hv * 128 + 32 * nd + r;
#pragma unroll
            for (int i = 0; i < 16; ++i) { const u16 w0 = f2bf(u0[i]), w1 = f2bf(u1[i]); if (!dry) { up[(size_t)crow(i, h) * LDG] = w0; up[(size_t)(32 + crow(i, h)) * LDG] = w1; } }
        }
    }
}

DI bf16x8 pk16(const f32x16& x, int s) { return pack8((f32x4){x[8 * s], x[8 * s + 1], x[8 * s + 2], x[8 * s + 3]}, (f32x4){x[8 * s + 4], x[8 * s + 5], x[8 * s + 6], x[8 * s + 7]}); }
DI bf16x8 pk16n(const f32x16& x, int s) { return pack8((f32x4){-x[8 * s], -x[8 * s + 1], -x[8 * s + 2], -x[8 * s + 3]}, (f32x4){-x[8 * s + 4], -x[8 * s + 5], -x[8 * s + 6], -x[8 * s + 7]}); }
DI void gd2_phase(const Params& p, int jl, unsigned char* smem, int bid, int nblk, int c_lo, int c_hi, bool dry) {
    u16* proj = (u16*)(p.ws + WS_PROJ); const u16* Abuf = (const u16*)(p.ws + WS_GA); const u16* Mw = (const u16*)(p.ws + WS_MW); const float* gcG = (const float*)(p.ws + WS_GC);
    const float* nw = p.in[21] + jl * 128;
    u16* knI = (u16*)smem; u16* qnI = knI + 64 * 136; u16* MwI = qnI + 64 * 136; u16* AI = MwI + 64 * 72; u16* uI = AI + 64 * 72;
    float* egS = (float*)(uI + 64 * 128); float* edS = egS + 64; float* Ob = edS + 64; float* nwS = Ob + 2 * 64 * 132;
    const int tid = opaque_tid(), wave = __builtin_amdgcn_readfirstlane(tid >> 6), lane = tid & 63, r = lane & 31, h = lane >> 5;
    const bool is_comp = wave < 4; const int dv0 = wave * 32, ht = tid - 256;
    for (int item = bid; item < 48; item += nblk) {
        const int b = item / 12, hv = item % 12, hq = hv >> 1;
        f32x16 S[4];
        float* sst = (float*)(p.ws + WS_SST) + (size_t)(item * 4 + (wave & 3)) * 4096 + lane;
#pragma unroll
        for (int i = 0; i < 4; ++i) S[i] = zero16();
        float gst = 0.f;
#define ST_SET(q, val) do { const u32x4 v_ = (val); S[(q) >> 2][((q) & 3) * 4] = __uint_as_float(v_.x); S[(q) >> 2][((q) & 3) * 4 + 1] = __uint_as_float(v_.y); S[(q) >> 2][((q) & 3) * 4 + 2] = __uint_as_float(v_.z); S[(q) >> 2][((q) & 3) * 4 + 3] = __uint_as_float(v_.w); } while (0)
#define ST_GET(q) ((u32x4){__float_as_uint(S[(q) >> 2][((q) & 3) * 4]), __float_as_uint(S[(q) >> 2][((q) & 3) * 4 + 1]), __float_as_uint(S[(q) >> 2][((q) & 3) * 4 + 2]), __float_as_uint(S[(q) >> 2][((q) & 3) * 4 + 3])})
#define GD2_LOAD(cc) do { int hl_ = ht; asm volatile("" : "+v"(hl_)); const int gch = b * 128 + (cc); const size_t t0 = (size_t)gch * 64; \
        _Pragma("unroll") for (int q = 0; q < 4; ++q) { const int e = hl_ + q * 256, row = e >> 4, ch = e & 15; const u16* rp = proj + (t0 + row) * LDG + ch * 8; \
            ST_SET(q, *(const u32x4*)(rp + G_K0 + hq * 128)); ST_SET(4 + q, *(const u32x4*)(rp + hq * 128)); ST_SET(8 + q, *(const u32x4*)(rp + G_V0 + hv * 128)); } \
        _Pragma("unroll") for (int q = 0; q < 2; ++q) { ST_SET(12 + q, *(const u32x4*)(Mw + ((size_t)gch * 12 + hv) * 4096 + (hl_ + q * 256) * 8)); ST_SET(14 + q, *(const u32x4*)(Abuf + ((size_t)gch * 12 + hv) * 4096 + (hl_ + q * 256) * 8)); } \
        if (hl_ < 64) gst = gcG[((size_t)gch * 12 + hv) * 64 + hl_]; } while (0)
#define GD2_STORE() do { int hl_ = ht; asm volatile("" : "+v"(hl_)); \
        _Pragma("unroll") for (int q = 0; q < 4; ++q) { const int e = hl_ + q * 256, row = e >> 4, ch = e & 15; \
            *(u32x4*)(knI + row * 136 + ch * 8) = ST_GET(q); *(u32x4*)(qnI + row * 136 + ch * 8) = ST_GET(4 + q); *(u32x4*)(uI + row * 128 + ch * 8) = ST_GET(8 + q); } \
        _Pragma("unroll") for (int q = 0; q < 2; ++q) { const int e = hl_ + q * 256, row = e >> 3, ch = e & 7; *(u32x4*)(MwI + row * 72 + ch * 8) = ST_GET(12 + q); *(u32x4*)(AI + row * 72 + ch * 8) = ST_GET(14 + q); } \
        if (hl_ < 64) { const float gl = __shfl(gst, 63); egS[hl_] = expf(gst); edS[hl_] = expf(gl - gst); } } while (0)
#define GD2_EPI(cc) do { int hl_ = ht; asm volatile("" : "+v"(hl_)); const int i = hl_ >> 2, sg = hl_ & 3; const float* orow = Ob + ((cc) & 1) * (64 * 132) + i * 132 + sg * 32; float ss = 0.f; \
        u16* rp = proj + (unsigned)(((b * 128 + (cc)) * 64 + i) * LDG); u32x4 GA[4]; \
        _Pragma("unroll") for (int q = 0; q < 8; ++q) { const f32x4 o = *(const f32x4*)(orow + 4 * q); ss += o[0] * o[0] + o[1] * o[1] + o[2] * o[2] + o[3] * o[3]; } \
        ss += __shfl_xor(ss, 1); ss += __shfl_xor(ss, 2); \
        const float rs = rsqrtf(ss * (1.f / 128.f) + 1e-6f); \
        _Pragma("unroll") for (int q = 0; q < 4; ++q) GA[q] = *(const u32x4*)(rp + G_GM + hv * 128 + sg * 32 + 8 * q);       \
        _Pragma("unroll") for (int q = 0; q < 4; ++q) { const u32x4 g0 = GA[q]; const f32x4 oa = *(const f32x4*)(orow + 8 * q), ob_ = *(const f32x4*)(orow + 8 * q + 4); \
            const f32x4 w0 = *(const f32x4*)(nwS + sg * 32 + 8 * q), w1 = *(const f32x4*)(nwS + sg * 32 + 8 * q + 4); u32x4 y; \
            y.x = pk2(oa[0] * rs * w0[0] * bflo(g0.x), oa[1] * rs * w0[1] * bfhi(g0.x)); y.y = pk2(oa[2] * rs * w0[2] * bflo(g0.y), oa[3] * rs * w0[3] * bfhi(g0.y)); \
            y.z = pk2(ob_[0] * rs * w1[0] * bflo(g0.z), ob_[1] * rs * w1[1] * bfhi(g0.z)); y.w = pk2(ob_[2] * rs * w1[2] * bflo(g0.w), ob_[3] * rs * w1[3] * bfhi(g0.w)); \
            if (!dry) *(u32x4*)(rp + G_V0 + hv * 128 + sg * 32 + 8 * q) = y; } } while (0)
        __syncthreads();
        if (tid < 128) nwS[tid] = nw[tid];
        if (!is_comp) { GD2_LOAD(c_lo); GD2_STORE(); }
        __syncthreads();
        if (is_comp && c_lo > 0) {
#pragma unroll
            for (int mt = 0; mt < 4; ++mt)
#pragma unroll
                for (int i = 0; i < 16; ++i) S[mt][i] = sst[(mt * 16 + i) * 64];
        }
        for (int c = c_lo; c < c_hi; ++c) {
            if (is_comp) {
                __builtin_amdgcn_s_setprio(2);
                f32x16 KS[2], O[2];
#pragma unroll
                for (int mk = 0; mk < 2; ++mk) { f32x16 a1 = zero16(), a2 = zero16();
                    bf16x8 kfv[8], qfv[8];
#pragma unroll
                    for (int ks = 0; ks < 8; ++ks) { const int off = (32 * mk + r) * 136 + 16 * ks + 4 * h;
                        kfv[ks] = cat44(*(const u32x2*)(knI + off), *(const u32x2*)(knI + off + 8)); qfv[ks] = cat44(*(const u32x2*)(qnI + off), *(const u32x2*)(qnI + off + 8)); }
                    __builtin_amdgcn_sched_barrier(0);
#pragma unroll
                    for (int ks = 0; ks < 8; ++ks) { const bf16x8 sb = pk16(S[ks >> 1], ks & 1); a1 = MFMA32(kfv[ks], sb, a1); a2 = MFMA32(qfv[ks], sb, a2); }
                    KS[mk] = a1; O[mk] = a2; }
                bf16x8 KSb[4];
#pragma unroll
                for (int mk = 0; mk < 2; ++mk) { KSb[2 * mk] = pk16n(KS[mk], 0); KSb[2 * mk + 1] = pk16n(KS[mk], 1); }
                bf16x8 vnb[4], vdb[4];
#pragma unroll
                for (int mk = 0; mk < 2; ++mk) { f32x16 vn; bf16x8 mf[4];
#pragma unroll
                    for (int i = 0; i < 16; ++i) vn[i] = bf2f(uI[(32 * mk + crow(i, h)) * 128 + dv0 + r]);
#pragma unroll
                    for (int ks = 0; ks < 4; ++ks) { const int off = (32 * mk + r) * 72 + 16 * ks + 4 * h; mf[ks] = cat44(*(const u32x2*)(MwI + off), *(const u32x2*)(MwI + off + 8)); }
                    __builtin_amdgcn_sched_barrier(0);
#pragma unroll
                    for (int ks = 0; ks < 4; ++ks) vn = MFMA32(mf[ks], KSb[ks], vn);
                    vnb[2 * mk] = pk16(vn, 0); vnb[2 * mk + 1] = pk16(vn, 1);
#pragma unroll
                    for (int i = 0; i < 16; ++i) vn[i] *= edS[32 * mk + crow(i, h)];
                    vdb[2 * mk] = pk16(vn, 0); vdb[2 * mk + 1] = pk16(vn, 1); }
#pragma unroll
                for (int mk = 0; mk < 2; ++mk) { f32x16 a2 = O[mk];
                    bf16x8 af[4];
#pragma unroll
                    for (int ks = 0; ks < 4; ++ks) { const int off = (32 * mk + r) * 72 + 16 * ks + 4 * h; af[ks] = cat44(*(const u32x2*)(AI + off), *(const u32x2*)(AI + off + 8)); }
#pragma unroll
                    for (int i = 0; i < 16; ++i) a2[i] *= egS[32 * mk + crow(i, h)];
                    __builtin_amdgcn_sched_barrier(0);
#pragma unroll
                    for (int ks = 0; ks < 4; ++ks) a2 = MFMA32(af[ks], vnb[ks], a2);
                    float* ob = Ob + (c & 1) * (64 * 132);
#pragma unroll
                    for (int i = 0; i < 16; ++i) ob[(32 * mk + crow(i, h)) * 132 + dv0 + r] = a2[i]; }
                const float egl = egS[63];
                const int li = lane & 15, tq = li >> 2, tp = li & 3, rsub = (lane >> 4) & 1;
#pragma unroll
                for (int mt = 0; mt < 4; ++mt) { f32x16 a1 = S[mt];
#pragma unroll
                    for (int i = 0; i < 16; ++i) a1[i] *= egl;
                    bf16x8 tf[4];
#pragma unroll
                    for (int ks = 0; ks < 4; ++ks) { const u16* ap = knI + (16 * ks + 4 * h + tq) * 136 + 32 * mt + 16 * rsub + 4 * tp;
                        const s16x4 lo = __builtin_amdgcn_ds_read_tr16_b64_v4i16((LAS s16x4*)(LAS u16*)ap), hi = __builtin_amdgcn_ds_read_tr16_b64_v4i16((LAS s16x4*)(LAS u16*)(ap + 8 * 136));
                        tf[ks] = __builtin_shufflevector(lo, hi, 0, 1, 2, 3, 4, 5, 6, 7); }
                    __builtin_amdgcn_sched_barrier(0);
#pragma unroll
                    for (int ks = 0; ks < 4; ++ks) a1 = MFMA32(tf[ks], vdb[ks], a1);
                    S[mt] = a1; }
                __builtin_amdgcn_s_setprio(0);
            } else {
                if (c + 1 < c_hi) GD2_LOAD(c + 1);
                if (c > c_lo) GD2_EPI(c - 1);
            }
            __syncthreads();
            if (!is_comp && c + 1 < c_hi) GD2_STORE();
            __syncthreads();
        }
        if (!is_comp) GD2_EPI(c_hi - 1);
        else if (c_hi < 128 && !dry) {
#pragma unroll
            for (int mt = 0; mt < 4; ++mt)
#pragma unroll
                for (int i = 0; i < 16; ++i) sst[(mt * 16 + i) * 64] = S[mt][i];
        }
#undef GD2_LOAD
#undef ST_SET
#undef ST_GET
#undef GD2_STORE
#undef GD2_EPI
    }
}

#define XB_TMO      128
#define XB_XCNT(j)  (256  + 64 * (j))
#define XB_XSUB(j)  (1280 + 64 * (j))
#define XB_XGEN(j)  (2304 + 64 * (j))
#define XB_TOP      3328
#define XB_TOPGEN   3392
#define XCD_BAR_WORDS 3456
#define XB_SPIN_CAP (1u << 18)
DI unsigned xb_ld(unsigned* p)              { return __hip_atomic_load(p, __ATOMIC_RELAXED, __HIP_MEMORY_SCOPE_AGENT); }
DI unsigned xb_add(unsigned* p, unsigned v) { return __hip_atomic_fetch_add(p, v, __ATOMIC_RELAXED, __HIP_MEMORY_SCOPE_AGENT); }
DI unsigned xb_xcc_id() { return (unsigned)__builtin_amdgcn_s_getreg((3 << 11) | 20) & 0xFu; }
#define XB_SPIN(cond, bar) do { unsigned _sp = 0; while (cond) { __builtin_amdgcn_s_sleep(1); \
    if ((++_sp & 255u) == 0u) { if (xb_ld(&(bar)[XB_TMO])) break; if (_sp > XB_SPIN_CAP) { atomicAdd(&(bar)[XB_TMO], 1u); break; } } } } while (0)
struct XcdBarrier { unsigned* bar; unsigned x; volatile LAS unsigned* st; };
DI XcdBarrier xcd_barrier_post(unsigned* bar, volatile LAS unsigned* st) {
    XcdBarrier b; b.bar = bar; b.x = xb_xcc_id(); b.st = st;
    if (threadIdx.x == 0) (void)xb_add(&bar[XB_XCNT(b.x)], 1u);
    return b;
}
DI void xcd_barrier_complete(unsigned* bar, unsigned x, unsigned& nloc, unsigned& nx) {
    const unsigned G = gridDim.x * gridDim.y * gridDim.z;
    unsigned sum, cnt, mine, sp = 0u;
    for (;;) {
        sum = 0u; cnt = 0u; mine = 0u;
#pragma unroll
        for (unsigned j = 0; j < 16; ++j) { const unsigned c = xb_ld(&bar[XB_XCNT(j)]); sum += c; cnt += (c > 0u) ? 1u : 0u; mine = (j == x) ? c : mine; }
        if (sum == G) break;
        __builtin_amdgcn_s_sleep(1);
        if ((++sp & 255u) == 0u) { if (xb_ld(&bar[XB_TMO])) break; if (sp > XB_SPIN_CAP) { atomicAdd(&bar[XB_TMO], 1u); break; } }
    }
    nloc = mine > 0u ? mine : 1u; nx = cnt > 0u ? cnt : 1u;
}
DI void xcd_barrier(const XcdBarrier& b) {
    asm volatile("s_waitcnt vmcnt(0)" ::: "memory");
    __syncthreads();
    if (threadIdx.x == 0) {
        unsigned* bar = b.bar;
        __builtin_amdgcn_s_waitcnt(0);
        unsigned nloc = b.st[0], nx = b.st[1];
        if (nloc == 0u) { xcd_barrier_complete(bar, b.x, nloc, nx); b.st[0] = nloc; b.st[1] = nx; }
        const unsigned old = xb_add(&bar[XB_XSUB(b.x)], 1u);
        const unsigned gen = old / nloc;
        if (old + 1u == (gen + 1u) * nloc) {
            __builtin_amdgcn_fence(__ATOMIC_RELEASE, "agent");
            asm volatile("s_waitcnt vmcnt(0)" ::: "memory");
            const unsigned og = xb_add(&bar[XB_TOP], 1u);
            const unsigned tg = og / nx;
            if (og + 1u == (tg + 1u) * nx) xb_add(&bar[XB_TOPGEN], 1u);
            else XB_SPIN(xb_ld(&bar[XB_TOPGEN]) == tg, bar);
            __builtin_amdgcn_fence(__ATOMIC_ACQUIRE, "agent");
            xb_add(&bar[XB_XGEN(b.x)], 1u);
            asm volatile("s_waitcnt vmcnt(0)" ::: "memory");
        } else {
            XB_SPIN(xb_ld(&bar[XB_XGEN(b.x)]) == gen, bar);
            __builtin_amdgcn_fence(__ATOMIC_ACQUIRE, "agent");
            asm volatile("s_waitcnt vmcnt(0)" ::: "memory");
        }
    }
    __syncthreads();
}

constexpr int NPIPE = 4;
constexpr int NPH_S5 = 7, NPH_GDN = NPIPE + 4, NPHASE = 2 * NPH_S5 + 2 * NPH_GDN + 1;
DI void decode_phase(int ph, int& layer, int& step) {
    if (ph < NPH_S5) { layer = 0; step = ph; } else if (ph < NPH_S5 + NPH_GDN) { layer = 1; step = ph - NPH_S5; } else if (ph < 2 * NPH_S5 + NPH_GDN) { layer = 2; step = ph - NPH_S5 - NPH_GDN; } else { layer = 3; step = ph - 2 * NPH_S5 - NPH_GDN; }
    if (layer & 1) { if (step >= 2) step = (step == NPH_GDN - 1) ? 6 : 8 + step; }
}
DI void run_phase(const Params& p, int ph, unsigned char* smem, int bid, int nblk, bool dry) {
    if (ph == NPHASE - 1) { if (!dry) final_norm(p.out, p.in[22], (const float*)(p.ws + WS_SSP), bid, nblk); return; }
    int layer, step; decode_phase(ph, layer, step);
    const bool s5 = (layer & 1) == 0; const int jl = layer >> 1;
    unsigned char* ws = p.ws;
    u16* proj = (u16*)(ws + WS_PROJ);
    LAS unsigned char* lds = (LAS unsigned char*)smem;
    const bool split = nblk > 48;
    bool do_gd2 = false, do_gd1 = false, do_xa = false; int g2_lo = 0, g2_hi = 0, g1_lo = 0, sb_bid = bid, sb_n = nblk, g2_n = nblk;
    if (s5) { do_xa = (step == 2); }
    else if (step == 10) { do_gd1 = true; g1_lo = 0; }
    else if (step > 10) {
        const int k = step - 10; const bool rec = !split || bid < 48, oth = !split || bid >= 48;
        do_gd2 = rec; g2_lo = (k - 1) * (128 / NPIPE); g2_hi = g2_lo + 128 / NPIPE; g2_n = split ? 48 : nblk;
        if (oth) { if (k < NPIPE) { do_gd1 = true; g1_lo = k * (128 / NPIPE); } else do_xa = true; if (split) { sb_bid = bid - 48; sb_n = nblk - 48; } }
    }
    if (step == 0) {
        float* tl = (float*)smem;
        if (s5 && (layer == 0 || !split)) {
                  transpose_w(p.in[6] + (size_t)jl * 1024 * 4096, 4096, (u16*)(ws + WS_WIN), 1024, 4096, 0, tl, bid, nblk);
                  transpose_w(p.in[15] + (size_t)jl * 1536 * 1536, 1536, (u16*)(ws + WS_WGLU), 1536, 1536, 0, tl, bid, nblk); }
        if (!s5)  transpose_w(p.in[17] + (size_t)jl * 1024 * 5656, 5656, (u16*)(ws + WS_WIN), 1024, NGP, 1, tl, bid, nblk);
        transpose_w(p.in[3] + (size_t)layer * 2048 * 1024, 1024, (u16*)(ws + WS_WOUT), 2048, 1024, 0, tl, bid, nblk);
        if (s5) s5_tables(p, jl, tl, bid, nblk);
        float* ssb = (float*)(ws + WS_SS);
        if (layer > 0) for (int i = bid * 512 + opaque_tid(); i < T_; i += nblk * 512) {
            const f32x4* pp = (const f32x4*)(ws + WS_SSP) + (size_t)i * 4; const f32x4 a0 = pp[0], a1 = pp[1], a2 = pp[2], a3 = pp[3];
            ssb[i] = ((a0[0] + a0[1]) + (a0[2] + a0[3])) + ((a1[0] + a1[1]) + (a1[2] + a1[3])) + ((a2[0] + a2[1]) + (a2[2] + a2[3])) + ((a3[0] + a3[1]) + (a3[2] + a3[3])); }
        if (layer == 0) {
            for (int l = 0; l < 4; ++l) { transpose_w(p.in[5] + (size_t)l * 1024 * 1024, 1024, (u16*)(ws + WS_WKV4) + (size_t)l * 1024 * 1024, 1024, 1024, 0, tl, bid, nblk);
                                          norm_rows_bf16(p.in[1], p.in[4] + l * 1024, (u16*)(ws + WS_MEMH4) + (size_t)l * 1024 * 1024, 1024, bid, nblk); }
            prep_rows(p.in[0], p.in[2], (u16*)(ws + WS_H), ssb, bid, nblk);
        }
        __syncthreads();
    }
    if (step == 1) {
        __syncthreads();
        if (s5) { pg8::Gemm g{(const u16*)(ws + WS_H), (const u16*)(ws + WS_WIN), T_, 4096, 1024, 1024}; pg8::StaticOrder S; S.init(T_, 4096, nblk, bid); EpiS5In E{proj, (const float*)(ws + WS_SS)}; pg8::gemm_phase(lds, g, S, E); }
        else    { pg8::Gemm g{(const u16*)(ws + WS_H), (const u16*)(ws + WS_WIN), T_, NGP, 1024, 1024}; pg8::StaticOrder S; S.init(T_, NGP, nblk, bid); EpiGdnIn E{proj, (float*)(ws + WS_AB), (u16*)(ws + WS_HALO), (const float*)(ws + WS_SS)}; pg8::gemm_phase(lds, g, S, E); }
        __syncthreads();
        if (layer == 0) for (int l = 0; l < 4; ++l) {
            pg8::Gemm g{(const u16*)(ws + WS_MEMH4) + (size_t)l * 1024 * 1024, (const u16*)(ws + WS_WKV4) + (size_t)l * 1024 * 1024, 1024, 1024, 1024, 1024}; pg8::StaticOrder S; S.init(1024, 1024, nblk, (bid + (nblk / 4) * l + nblk / 8) % nblk);
            EpiKV E{(u16*)(ws + WS_KMVT + (size_t)l * 2 * MiB), (u16*)(ws + WS_KMVT + (size_t)l * 2 * MiB) + 512 * 1024}; pg8::gemm_phase(lds, g, S, E); __syncthreads(); }
    }
    if (do_gd2) gd2_phase(p, jl, smem, bid, g2_n, g2_lo, g2_hi, dry);
    if (do_gd1) gd1_phase(p, jl, smem, sb_bid, sb_n, g1_lo, 128 / NPIPE, dry);
    const bool early_w = !s5 && layer == 1 && split && step == 10 + NPIPE && bid >= 48;
    if (do_xa) xattn_phase(p, layer, s5 ? LDS5 : LDG, s5 ? 3072 : G_QX, s5 ? 3584 : G_GX, smem, sb_bid, sb_n, dry);
    if (early_w) { float* tl = (float*)smem;
        transpose_w(p.in[6] + (size_t)(jl + 1) * 1024 * 4096, 4096, (u16*)(ws + WS_WIN), 1024, 4096, 0, tl, sb_bid, sb_n);
        transpose_w(p.in[15] + (size_t)(jl + 1) * 1536 * 1536, 1536, (u16*)(ws + WS_WGLU), 1536, 1536, 0, tl, sb_bid, sb_n); }
    if (s5 && step == 2) s5a_phase(p, smem, bid, nblk);
    if (s5 && step == 3) s5b_phase(p, (float*)smem, bid, nblk, dry);
    if (s5 && step == 4) s5c_phase(p, smem, bid, nblk, dry);
    if (step == 5) {
        __syncthreads();
        pg8::Gemm g{proj, (const u16*)(ws + WS_WGLU), T_, 1536, 1536, LDS5}; pg8::StaticOrder S; S.init(T_, 1536, nblk, bid); EpiGlu E{proj, p.in[16] + jl * 1536, dry}; pg8::gemm_phase(lds, g, S, E);
    }
    if (step == 6) {
        __syncthreads();
        pg8::Gemm g{proj + (s5 ? 1536 : G_V0), (const u16*)(ws + WS_WOUT), T_, 1024, 2048, s5 ? LDS5 : LDG}; pg8::StaticOrder S; S.init(T_, 1024, nblk, bid);
        EpiOut E{layer == 0 ? p.in[0] : p.out, p.out, dry, layer < 3 ? p.in[2] + (layer + 1) * 1024 : nullptr, (u16*)(ws + WS_H), (float*)(ws + WS_SSP)}; pg8::gemm_phase(lds, g, S, E);
    }
    __syncthreads();
}

__global__ void __launch_bounds__(512) fwd_megakernel(Params p) {
    extern __shared__ __attribute__((aligned(16))) unsigned char smem[];
    const int bid = blockIdx.x, nblk = gridDim.x;
#if MK_MULTI
    for (int ph = p.ph_lo; ph < p.ph_hi; ++ph) run_phase(p, ph, smem, bid, nblk, false);
#else
    cg::grid_group grid = cg::this_grid();
    volatile LAS unsigned* bst = (volatile LAS unsigned*)((LAS unsigned char*)smem + LDS_BYTES - 16);
    if (threadIdx.x < 2) bst[threadIdx.x] = 0u;
    __syncthreads();
    (void)xcd_barrier_post((unsigned*)(p.ws + WS_BAR), bst);
#define GRID_SYNC(first) do { if (first) grid.sync(); else { XcdBarrier xb_; xb_.bar = (unsigned*)(p.ws + WS_BAR); xb_.x = xb_xcc_id(); xb_.st = (volatile LAS unsigned*)((LAS unsigned char*)smem + LDS_BYTES - 16); xcd_barrier(xb_); } } while (0)
    for (int ph = p.ph_lo; ph < p.ph_hi; ++ph) {
        int lay_, st_; decode_phase(ph, lay_, st_);
        const bool dup = (ph < NPHASE - 1) && ((lay_ & 1) == p.dup_kind) && (st_ == p.dup_step);
        for (int rep_ = dup ? 0 : 1; rep_ < 2; ++rep_) { run_phase(p, ph, smem, bid, nblk, rep_ == 0); if (rep_ == 0) GRID_SYNC(false); }
        if (p.dup_step == 99) GRID_SYNC(false);
        if (ph + 1 < p.ph_hi) GRID_SYNC(ph == p.ph_lo);
    }
#endif
}

extern "C" void kernel_launch(void* const* d_in, const int* in_sizes, int n_in, void* d_out, int out_size, void* d_ws, size_t ws_size, hipStream_t stream) {
    static int grid = 0;
    if (grid == 0) {
        if (n_in != 23 || ws_size < WS_END) { fprintf(stderr, "kernel_launch: need 23 inputs and %zu bytes of workspace (got %d, %zu)\n", (size_t)WS_END, n_in, ws_size); grid = -1; return; }
        int dev = 0, cus = 0, per_cu = 0;
        hipGetDevice(&dev); hipDeviceGetAttribute(&cus, hipDeviceAttributeMultiprocessorCount, dev);
        if (hipFuncSetAttribute((const void*)fwd_megakernel, hipFuncAttributeMaxDynamicSharedMemorySize, LDS_BYTES) != hipSuccess) { fprintf(stderr, "kernel_launch: hipFuncSetAttribute failed\n"); grid = -1; return; }
        hipOccupancyMaxActiveBlocksPerMultiprocessor(&per_cu, (const void*)fwd_megakernel, 512, LDS_BYTES);
        if (per_cu < 1) { fprintf(stderr, "kernel_launch: occupancy query returned %d\n", per_cu); per_cu = 1; }
        grid = cus * (per_cu > 1 ? 1 : per_cu);
        (void)hipGetLastError();
    }
    if (grid < 0) return;
    Params p{};
    for (int i = 0; i < 23; ++i) p.in[i] = (const float*)d_in[i];
    p.out = (float*)d_out; p.ws = (unsigned char*)d_ws;
#if MK_MULTI
    for (int ph = 0; ph < NPHASE; ++ph) { p.ph_lo = ph; p.ph_hi = ph + 1; hipLaunchKernelGGL(fwd_megakernel, dim3(grid), dim3(512), LDS_BYTES, stream, p); }
#else
    p.ph_lo = 0; p.ph_hi = NPHASE; p.dup_kind = DUP_KIND; p.dup_step = DUP_STEP; p.dbg = DBG_STOP;
    if (hipMemsetAsync((char*)d_ws + WS_BAR, 0, XCD_BAR_WORDS * 4, stream) != hipSuccess) { fprintf(stderr, "kernel_launch: memset of the barrier words failed\n"); return; }
    void* args[] = {&p};
    hipError_t e = hipLaunchCooperativeKernel((const void*)fwd_megakernel, dim3(grid), dim3(512), args, LDS_BYTES, stream);
    if (e != hipSuccess) fprintf(stderr, "cooperative launch failed: %s (grid %d)\n", hipGetErrorString(e), grid);
#endif
}
```

```cpp
#include <hip/hip_runtime.h>
#include <hip/hip_cooperative_groups.h>
#include <cstdio>
namespace cg = cooperative_groups;

#define DUP_KIND -1
#define DBG_STOP 99
#define DUP_STEP -1
#ifndef MK_MULTI
#define MK_MULTI 0
#endif

typedef unsigned short u16;
typedef short bf16x8 __attribute__((ext_vector_type(8)));
typedef short s16x4 __attribute__((ext_vector_type(4)));
typedef float f32x2 __attribute__((ext_vector_type(2)));
typedef float f32x4 __attribute__((ext_vector_type(4)));
typedef float f32x16 __attribute__((ext_vector_type(16)));
typedef unsigned u32x2 __attribute__((ext_vector_type(2)));
typedef unsigned u32x4 __attribute__((ext_vector_type(4)));
typedef __bf16 bf16x2_t __attribute__((ext_vector_type(2)));
#define LAS __attribute__((address_space(3)))
#define DI __device__ __forceinline__

constexpr int T_ = 32768, D_ = 1024, SEQ = 8192;
constexpr int LDS5 = 4096, LDG = 5632, NGP = 5888;
constexpr int G_K0 = 768, G_V0 = 1536, G_QX = 3072, G_GM = 3584, G_GX = 5120;
constexpr size_t MiB = 1u << 20;
constexpr size_t WS_WIN = 0, WS_WGLU = 12 * MiB, WS_WOUT = 17 * MiB, WS_KMVT = 21 * MiB;
constexpr size_t WS_H = 29 * MiB;
constexpr size_t WS_GA = WS_H, WS_GC = WS_H + 48 * MiB;
constexpr size_t WS_PROJ = 93 * MiB;
constexpr size_t WS_MW = 445 * MiB, WS_AB = 493 * MiB, WS_HALO = 496 * MiB;
constexpr size_t WS_XLOC = WS_PROJ + 256 * MiB;
constexpr size_t WS_KT = 449 * MiB, WS_BC = 450 * MiB, WS_CC = 456 * MiB, WS_A16 = 462 * MiB;
constexpr size_t WS_WKV4 = WS_XLOC, WS_MEMH4 = WS_XLOC + 8 * MiB;
constexpr size_t WS_SST = 505 * MiB;
constexpr size_t WS_BAR = 508 * MiB;
constexpr size_t WS_SS = 508 * MiB + 65536;
constexpr size_t WS_SSP = 509 * MiB;
constexpr size_t WS_END = 511 * MiB;
constexpr int LDS_BYTES = 144 * 1024;

struct Params { const float* in[23]; float* out; unsigned char* ws; int ph_lo, ph_hi, dup_kind, dup_step, dbg, pad; };

DI unsigned pk2(float lo, float hi) { f32x2 v = {lo, hi}; bf16x2_t b = __builtin_convertvector(v, bf16x2_t); return __builtin_bit_cast(unsigned, b); }
DI u16 f2bf(float f) { return (u16)(pk2(f, 0.f) & 0xffffu); }
DI float bf2f(u16 b) { return __uint_as_float(((unsigned)b) << 16); }
DI float bflo(unsigned u) { return __uint_as_float(u << 16); }
DI float bfhi(unsigned u) { return __uint_as_float(u & 0xffff0000u); }
DI bf16x8 pack8(f32x4 a, f32x4 b) { u32x4 w; w.x = pk2(a[0], a[1]); w.y = pk2(a[2], a[3]); w.z = pk2(b[0], b[1]); w.w = pk2(b[2], b[3]); return __builtin_bit_cast(bf16x8, w); }
DI float wave_sum(float v) { for (int m = 32; m >= 1; m >>= 1) v += __shfl_xor(v, m); return v; }
DI float silu_f(float x) { return x * __builtin_amdgcn_rcpf(1.f + __expf(-x)); }
DI float sigmoid_f(float x) { return __builtin_amdgcn_rcpf(1.f + __expf(-x)); }
DI float gelu_tanh(float x) { float u = 0.7978845608028654f * (x + 0.044715f * x * x * x); float e = __expf(2.f * u); float th = 1.f - 2.f * __builtin_amdgcn_rcpf(e + 1.f); return 0.5f * x * (1.f + th); }
DI int crow(int reg, int h) { return (reg & 3) + 8 * (reg >> 2) + 4 * h; }
#define MFMA32(a, b, c) __builtin_amdgcn_mfma_f32_32x32x16_bf16((a), (b), (c), 0, 0, 0)
#define MFMA16(a, b, c) __builtin_amdgcn_mfma_f32_16x16x32_bf16((a), (b), (c), 0, 0, 0)
DI bf16x8 cat44(u32x2 lo, u32x2 hi) { u32x4 w = {lo.x, lo.y, hi.x, hi.y}; return __builtin_bit_cast(bf16x8, w); }
DI int opaque_tid() { int t = (int)threadIdx.x; asm volatile("" : "+v"(t)); return t; }
DI f32x16 zero16() { f32x16 z; for (int i = 0; i < 16; ++i) z[i] = 0.f; return z; }

namespace pg8 {
constexpr int BM = 256, BK = 64, HALF = 128, HTB = HALF * BK * 2, NXCD = 8, WGM = 8;
DI int lds_byte(int r, int c) { const int st = (r >> 4) * 2 + (c >> 5), rr = r & 15, cc = c & 31, ob = rr * 64 + cc * 2; return st * 1024 + (ob ^ (((ob >> 9) & 1) << 5)); }
DI void stage_rc(int b, int& R, int& C) { const int st = b / 1024, sb = b % 1024, swz = sb ^ (((sb >> 9) & 1) << 5); R = (st >> 1) * 16 + swz / 64; C = (st & 1) * 32 + (swz % 64) / 2; }
DI int perm32(int rho) { const int n = rho >> 4, i = rho & 15; return 8 * (i >> 2) + 4 * n + (i & 3); }
struct Unit { int pm, pn; };
struct Gemm { const u16* A; const u16* Bt; int M, N, K, lda; };
struct StaticOrder {
    int nM, nN, nwg, G, c;
    DI void init(int M, int N, int G_, int c_) { nM = M / BM; nN = N / BM; nwg = nM * nN; G = G_; c = c_; }
    DI bool next(int i, Unit& u) const {
        const long L = (long)i * G + c; if (L >= nwg) return false;
        int wgid = (int)L; { const int q = nwg / NXCD, r = nwg % NXCD, xcd = wgid % NXCD, off = wgid / NXCD; wgid = (xcd < r ? xcd * (q + 1) : r * (q + 1) + (xcd - r) * q) + off; }
        const int nig = WGM * nN, gid = wgid / nig, fm = gid * WGM, gsz = (nM - fm) < WGM ? (nM - fm) : WGM;
        u.pm = fm + ((wgid % nig) % gsz); u.pn = (wgid % nig) / gsz; return true;
    }
};

template <class Epi>
DI void gemm_phase(LAS unsigned char* lds, const Gemm g, const StaticOrder& S, const Epi& E) {
    const int tid = opaque_tid(), wid = __builtin_amdgcn_readfirstlane(tid >> 6), lane = tid & 63, wr = wid >> 2, wc = wid & 3, fr = lane & 15, fq = lane >> 4;
    const int K = g.K, nt = K / BK, lda = g.lda;
    unsigned voffA[2], voffB[2];
#pragma unroll
    for (int i = 0; i < 2; ++i) { int R, C; stage_rc(tid * 16 + i * 8192, R, C); const int Rb = Epi::PERM ? ((R & ~31) + perm32(R & 31)) : R;
        voffA[i] = (unsigned)(R * lda + C) * 2u; voffB[i] = (unsigned)(Rb * K + C) * 2u; }
    const size_t kstep = (size_t)(BK * 2);
    const size_t hstepA = (size_t)HALF * lda * 2, hstepB = (size_t)HALF * K * 2;
    const size_t tstepA = 2 * hstepA, tstepB = 2 * hstepB;
    const unsigned ldsw = (unsigned)wid * 1024u;
    const int aoff = lds_byte(wr * 64 + fr, fq * 8), boff = lds_byte(wc * 32 + fr, fq * 8);
#define PG8_SA(b, h) (((b) * 2 + (h)) * HTB)
#define PG8_SB(b, h) ((4 + (b) * 2 + (h)) * HTB)
#define PG8_STAGE(bufoff, gbase, voff) do { _Pragma("unroll") for (int _i = 0; _i < 2; ++_i) \
        __builtin_amdgcn_global_load_lds((const unsigned*)((const char*)(gbase) + (voff)[_i]), (LAS unsigned*)(lds + (bufoff) + ldsw + _i * 8192), 16, 0, 0); } while (0)
#define PG8_LDA(dst, b, h) do { _Pragma("unroll") for (int m = 0; m < 4; ++m) _Pragma("unroll") for (int k = 0; k < 2; ++k) dst[m][k] = *(const LAS bf16x8*)(lds + PG8_SA(b, h) + aoff + m * 2048 + k * 1024); } while (0)
#define PG8_LDB(dst, b, h) do { _Pragma("unroll") for (int n = 0; n < 2; ++n) _Pragma("unroll") for (int k = 0; k < 2; ++k) dst[n][k] = *(const LAS bf16x8*)(lds + PG8_SB(b, h) + boff + n * 2048 + k * 1024); } while (0)
#define PG8_MMA(ai, bj, At, Bt) do { __builtin_amdgcn_s_setprio(1); _Pragma("unroll") for (int m = 0; m < 4; ++m) _Pragma("unroll") for (int n = 0; n < 2; ++n) _Pragma("unroll") for (int k = 0; k < 2; ++k) \
        acc[ai][bj][m][n] = __builtin_amdgcn_mfma_f32_16x16x32_bf16(Bt[n][k], At[m][k], acc[ai][bj][m][n], 0, 0, 0); __builtin_amdgcn_s_setprio(0); } while (0)
#define PG8_WAIT_V(n) asm volatile("s_waitcnt vmcnt(" #n ")" ::: "memory")
#define PG8_WAIT_L(n) asm volatile("s_waitcnt lgkmcnt(" #n ")" ::: "memory")
#define PG8_BAR __builtin_amdgcn_s_barrier()
#define PG8_SCHED __builtin_amdgcn_sched_barrier(0)
    Unit cur, nxt; int ui = 0;
    if (!S.next(0, cur)) return;
    f32x4 acc[2][2][4][2];
#pragma unroll
    for (int a = 0; a < 2; ++a)
#pragma unroll
        for (int b = 0; b < 2; ++b)
#pragma unroll
            for (int m = 0; m < 4; ++m)
#pragma unroll
                for (int n = 0; n < 2; ++n) acc[a][b][m][n] = (f32x4){0.f, 0.f, 0.f, 0.f};
    bf16x8 At[4][2], B0[2][2], B1[2][2];
    const char* cA = (const char*)g.A + (size_t)cur.pm * tstepA; const char* cB = (const char*)g.Bt + (size_t)cur.pn * tstepB;
    PG8_STAGE(PG8_SB(0, 0), cB, voffB); PG8_STAGE(PG8_SB(0, 1), cB + hstepB, voffB); PG8_STAGE(PG8_SA(0, 0), cA, voffA); PG8_STAGE(PG8_SA(0, 1), cA + hstepA, voffA);
    if (wr == 1) PG8_BAR;
    PG8_WAIT_V(2); PG8_BAR;
    PG8_STAGE(PG8_SB(1, 0), cB + kstep, voffB); PG8_STAGE(PG8_SA(1, 0), cA + kstep, voffA); PG8_STAGE(PG8_SB(1, 1), cB + hstepB + kstep, voffB);
    PG8_WAIT_V(6); PG8_BAR;
    for (;;) {
        const bool has_next = S.next(ui + 1, nxt);
        const char* nA = has_next ? (const char*)g.A + (size_t)nxt.pm * tstepA : cA; const char* nB = has_next ? (const char*)g.Bt + (size_t)nxt.pn * tstepB : cB;
        for (int t = 0; t < nt; t += 2) {
            const bool last = (t == nt - 2);
            const char* a1 = cA + (size_t)(t + 1) * kstep;
            const char* a2 = last ? nA : cA + (size_t)(t + 2) * kstep; const char* b2 = last ? nB : cB + (size_t)(t + 2) * kstep;
            const char* a3 = a2 + kstep; const char* b3 = b2 + kstep;
            PG8_LDB(B0, 0, 0); PG8_LDB(B1, 0, 1); PG8_SCHED; PG8_LDA(At, 0, 0); PG8_STAGE(PG8_SA(1, 1), a1 + hstepA, voffA);
            PG8_WAIT_V(8); PG8_WAIT_L(0); PG8_BAR; PG8_MMA(0, 0, At, B0); PG8_MMA(0, 1, At, B1); PG8_BAR; PG8_SCHED;
            PG8_LDA(At, 0, 1); PG8_STAGE(PG8_SB(0, 0), b2, voffB); PG8_STAGE(PG8_SB(0, 1), b2 + hstepB, voffB); PG8_STAGE(PG8_SA(0, 0), a2, voffA);
            PG8_WAIT_V(8); PG8_WAIT_L(0); PG8_BAR; PG8_MMA(1, 0, At, B0); PG8_MMA(1, 1, At, B1); PG8_BAR; PG8_SCHED;
            PG8_LDB(B0, 1, 0); PG8_LDB(B1, 1, 1); PG8_SCHED; PG8_LDA(At, 1, 0); PG8_STAGE(PG8_SA(0, 1), a2 + hstepA, voffA);
            PG8_WAIT_V(8); PG8_WAIT_L(0); PG8_BAR; PG8_MMA(0, 0, At, B0); PG8_MMA(0, 1, At, B1); PG8_BAR; PG8_SCHED;
            PG8_LDA(At, 1, 1); PG8_STAGE(PG8_SB(1, 0), b3, voffB); PG8_STAGE(PG8_SB(1, 1), b3 + hstepB, voffB); PG8_STAGE(PG8_SA(1, 0), a3, voffA);
            PG8_WAIT_V(8); PG8_WAIT_L(0); PG8_BAR; PG8_MMA(1, 0, At, B0); PG8_MMA(1, 1, At, B1); PG8_BAR; PG8_SCHED;
        }
        if (wr == 0) PG8_BAR;
        E(acc, cur, wr, wc, fr, fq);
        if (!has_next) break;
#pragma unroll
        for (int a = 0; a < 2; ++a)
#pragma unroll
            for (int b = 0; b < 2; ++b)
#pragma unroll
                for (int m = 0; m < 4; ++m)
#pragma unroll
                    for (int n = 0; n < 2; ++n) acc[a][b][m][n] = (f32x4){0.f, 0.f, 0.f, 0.f};
        cur = nxt; cA = nA; cB = nB; ++ui;
        if (wr == 1) PG8_BAR;
    }
    PG8_WAIT_V(0);
    PG8_BAR;
#undef PG8_SA
#undef PG8_SB
#undef PG8_STAGE
#undef PG8_LDA
#undef PG8_LDB
#undef PG8_MMA
#undef PG8_WAIT_V
#undef PG8_WAIT_L
#undef PG8_BAR
#undef PG8_SCHED
}
}

#define EPI_LOOP_PERM(body) \
    _Pragma("unroll") for (int ai = 0; ai < 2; ++ai) _Pragma("unroll") for (int m = 0; m < 4; ++m) { const int row = u.pm * 256 + ai * 128 + wr * 64 + m * 16 + fr; \
    _Pragma("unroll") for (int bj = 0; bj < 2; ++bj) { const int col = u.pn * 256 + bj * 128 + wc * 32 + 8 * fq; f32x4 v0 = acc[ai][bj][m][0], v1 = acc[ai][bj][m][1]; body } }

struct EpiS5In {
    static constexpr bool PERM = true;
    u16* proj; const float* ss;
    DI void operator()(const f32x4 (&acc)[2][2][4][2], const pg8::Unit& u, int wr, int wc, int fr, int fq) const {
        const bool act = (u.pn >= 6 && u.pn < 12) || u.pn >= 14;
        float rsv[2][4];
#pragma unroll
        for (int ai = 0; ai < 2; ++ai)
#pragma unroll
            for (int m = 0; m < 4; ++m) rsv[ai][m] = ss[u.pm * 256 + ai * 128 + wr * 64 + m * 16 + fr];
#pragma unroll
        for (int ai = 0; ai < 2; ++ai)
#pragma unroll
            for (int m = 0; m < 4; ++m) rsv[ai][m] = rsqrtf(rsv[ai][m] * (1.f / 1024.f) + 1e-6f);
        EPI_LOOP_PERM(
            { const float rs = rsv[ai][m]; v0 *= rs; v1 *= rs; }
            if (act) { for (int j = 0; j < 4; ++j) { v0[j] = silu_f(v0[j]); v1[j] = silu_f(v1[j]); } }
            __builtin_nontemporal_store(__builtin_bit_cast(u32x4, pack8(v0, v1)), (u32x4*)(proj + (size_t)row * LDS5 + col));
        )
    }
};
struct EpiGdnIn {
    static constexpr bool PERM = true;
    u16* proj; float* ab; u16* halo; const float* ss;
    DI void operator()(const f32x4 (&acc)[2][2][4][2], const pg8::Unit& u, int wr, int wc, int fr, int fq) const {
        const int pn = u.pn;
        float rsv[2][4];
#pragma unroll
        for (int ai = 0; ai < 2; ++ai)
#pragma unroll
            for (int m = 0; m < 4; ++m) rsv[ai][m] = ss[u.pm * 256 + ai * 128 + wr * 64 + m * 16 + fr];
#pragma unroll
        for (int ai = 0; ai < 2; ++ai)
#pragma unroll
            for (int m = 0; m < 4; ++m) rsv[ai][m] = rsqrtf(rsv[ai][m] * (1.f / 1024.f) + 1e-6f);
        EPI_LOOP_PERM(
            { const float rs = rsv[ai][m]; v0 *= rs; v1 *= rs; }
            if (pn < 22) {
                if (pn >= 14) { for (int j = 0; j < 4; ++j) { v0[j] = silu_f(v0[j]); v1[j] = silu_f(v1[j]); } }
                const u32x4 w = __builtin_bit_cast(u32x4, pack8(v0, v1));
                __builtin_nontemporal_store(w, (u32x4*)(proj + (size_t)row * LDG + col));
                if (pn < 12 && (row & 63) >= 61) __builtin_nontemporal_store(w, (u32x4*)(halo + ((size_t)(row >> 6) * 3 + ((row & 63) - 61)) * 3072 + col));
            } else {
                const int c = col - LDG;
                if (c < 24) { __builtin_nontemporal_store(v0, (f32x4*)(ab + (size_t)row * 24 + c)); __builtin_nontemporal_store(v1, (f32x4*)(ab + (size_t)row * 24 + c + 4)); }
            }
        )
    }
};
struct EpiKV {
    static constexpr bool PERM = true;
    u16* km; u16* vt;
    DI void operator()(const f32x4 (&acc)[2][2][4][2], const pg8::Unit& u, int wr, int wc, int fr, int fq) const {
        EPI_LOOP_PERM(
            if (col < 512) *(u32x4*)(km + (size_t)row * 512 + col) = __builtin_bit_cast(u32x4, pack8(v0, v1));
            else { for (int j = 0; j < 4; ++j) { vt[(size_t)(col - 512 + j) * 1024 + row] = f2bf(v0[j]); vt[(size_t)(col - 512 + 4 + j) * 1024 + row] = f2bf(v1[j]); } }
        )
    }
};
struct EpiGlu {
    static constexpr bool PERM = true;
    u16* proj; const float* bglu; bool dry;
    DI void operator()(const f32x4 (&acc)[2][2][4][2], const pg8::Unit& u, int wr, int wc, int fr, int fq) const {
        f32x4 bb[2][2];
#pragma unroll
        for (int bj = 0; bj < 2; ++bj) { const int col = u.pn * 256 + bj * 128 + wc * 32 + 8 * fq; bb[bj][0] = *(const f32x4*)(bglu + col); bb[bj][1] = *(const f32x4*)(bglu + col + 4); }
#pragma unroll
        for (int aim = 0; aim < 4; ++aim) { const int ai = aim >> 1, m0 = (aim & 1) * 2;
            u32x4 ygv[4][2], sgv[4][2];
#pragma unroll
            for (int m = m0; m < m0 + 2; ++m)
#pragma unroll
                for (int bj = 0; bj < 2; ++bj) { const u16* rp = proj + (size_t)(u.pm * 256 + ai * 128 + wr * 64 + m * 16 + fr) * LDS5 + u.pn * 256 + bj * 128 + wc * 32 + 8 * fq;
                    ygv[m][bj] = *(const u32x4*)rp; sgv[m][bj] = *(const u32x4*)(rp + 1536); }
#pragma unroll
            for (int m = m0; m < m0 + 2; ++m)
#pragma unroll
                for (int bj = 0; bj < 2; ++bj) { const f32x4 v0 = acc[ai][bj][m][0], v1 = acc[ai][bj][m][1], b0 = bb[bj][0], b1 = bb[bj][1]; const u32x4 yg = ygv[m][bj], sg = sgv[m][bj];
                    u16* gp = proj + (size_t)(u.pm * 256 + ai * 128 + wr * 64 + m * 16 + fr) * LDS5 + 1536 + u.pn * 256 + bj * 128 + wc * 32 + 8 * fq;
                    f32x4 o0; f32x4 o1;
                    o0[0] = bflo(yg.x) * sigmoid_f(v0[0] + b0[0]) * bflo(sg.x); o0[1] = bfhi(yg.x) * sigmoid_f(v0[1] + b0[1]) * bfhi(sg.x);
                    o0[2] = bflo(yg.y) * sigmoid_f(v0[2] + b0[2]) * bflo(sg.y); o0[3] = bfhi(yg.y) * sigmoid_f(v0[3] + b0[3]) * bfhi(sg.y);
                    o1[0] = bflo(yg.z) * sigmoid_f(v1[0] + b1[0]) * bflo(sg.z); o1[1] = bfhi(yg.z) * sigmoid_f(v1[1] + b1[1]) * bfhi(sg.z);
                    o1[2] = bflo(yg.w) * sigmoid_f(v1[2] + b1[2]) * bflo(sg.w); o1[3] = bfhi(yg.w) * sigmoid_f(v1[3] + b1[3]) * bfhi(sg.w);
                    if (!dry) *(u32x4*)gp = __builtin_bit_cast(u32x4, pack8(o0, o1)); }
        }
    }
};
struct EpiOut {
    static constexpr bool PERM = true;
    const float* xin; float* xout; bool dry; const float* wnext; u16* h; float* ssn;
    DI void operator()(const f32x4 (&acc)[2][2][4][2], const pg8::Unit& u, int wr, int wc, int fr, int fq) const {
        f32x4 wn[2][2];
#pragma unroll
        for (int bj = 0; bj < 2; ++bj)
#pragma unroll
            for (int n = 0; n < 2; ++n) wn[bj][n] = wnext ? *(const f32x4*)(wnext + u.pn * 256 + bj * 128 + wc * 32 + 8 * fq + 4 * n) : (f32x4){0.f, 0.f, 0.f, 0.f};
#pragma unroll
        for (int aim = 0; aim < 4; ++aim) { const int ai = aim >> 1, m0 = (aim & 1) * 2;
            f32x4 xi[4][2][2];
#pragma unroll
            for (int m = m0; m < m0 + 2; ++m)
#pragma unroll
                for (int bj = 0; bj < 2; ++bj)
#pragma unroll
                    for (int n = 0; n < 2; ++n) xi[m][bj][n] = *(const f32x4*)(xin + (size_t)(u.pm * 256 + ai * 128 + wr * 64 + m * 16 + fr) * D_ + u.pn * 256 + bj * 128 + wc * 32 + 8 * fq + 4 * n);
#pragma unroll
            for (int m = m0; m < m0 + 2; ++m) { const size_t row = (size_t)(u.pm * 256 + ai * 128 + wr * 64 + m * 16 + fr); float sq = 0.f;
#pragma unroll
                for (int bj = 0; bj < 2; ++bj) { const int col = u.pn * 256 + bj * 128 + wc * 32 + 8 * fq;
                    const f32x4 x0 = xi[m][bj][0] + acc[ai][bj][m][0], x1 = xi[m][bj][1] + acc[ai][bj][m][1];
                    sq += x0[0] * x0[0] + x0[1] * x0[1] + x0[2] * x0[2] + x0[3] * x0[3] + x1[0] * x1[0] + x1[1] * x1[1] + x1[2] * x1[2] + x1[3] * x1[3];
                    if (!dry) { __builtin_nontemporal_store(x0, (f32x4*)(xout + row * D_ + col)); __builtin_nontemporal_store(x1, (f32x4*)(xout + row * D_ + col + 4));
                        if (wnext) *(u32x4*)(h + row * D_ + col) = __builtin_bit_cast(u32x4, pack8(x0 * wn[bj][0], x1 * wn[bj][1])); } }
                sq += __shfl_xor(sq, 16); sq += __shfl_xor(sq, 32);
                if (fq == 0 && !dry) ssn[row * 16 + u.pn * 4 + wc] = sq; }
        }
    }
};

DI int gdn_map(int n) { if (n < 3072) return n; if (n < 3584) return n + 1560; if (n < 5120) return n - 488; if (n < 5632) return n + 24; if (n < 5656) return n - 2560; return -1; }
DI void transpose_w(const float* src, int Nsrc, u16* dst, int K, int Ndst, int mode, float* tl, int bid, int nblk) {
    const int nkt = K / 64, nnt = Ndst / 64, ntile = nkt * nnt, tid = opaque_tid();
    for (int tb = bid * 4; tb < ntile; tb += nblk * 4) {
        __syncthreads();
        float v[4][8];
#pragma unroll
        for (int u = 0; u < 4; ++u) { const int t = tb + u; const int kt = t % nkt, nt_ = t / nkt, k0 = kt * 64, n0 = nt_ * 64;
#pragma unroll
            for (int q = 0; q < 8; ++q) { const int e = tid + q * 512, kk = e >> 6, nn = e & 63; const int n = n0 + nn; const int sc = mode ? gdn_map(n) : n;
                v[u][q] = (t < ntile && sc >= 0) ? src[(size_t)(k0 + kk) * Nsrc + sc] : 0.f; } }
#pragma unroll
        for (int u = 0; u < 4; ++u)
#pragma unroll
            for (int q = 0; q < 8; ++q) { const int e = tid + q * 512, kk = e >> 6, nn = e & 63; tl[u * 4160 + nn * 65 + kk] = v[u][q]; }
        __syncthreads();
#pragma unroll
        for (int u = 0; u < 4; ++u) { const int t = tb + u; if (t < ntile) { const int kt = t % nkt, nt_ = t / nkt, k0 = kt * 64, n0 = nt_ * 64;
#pragma unroll
            for (int q = 0; q < 4; ++q) { const int e = tid + q * 512, nn = e >> 5, kk = (e & 31) * 2;
                *(unsigned*)(dst + (size_t)(n0 + nn) * K + k0 + kk) = pk2(tl[u * 4160 + nn * 65 + kk], tl[u * 4160 + nn * 65 + kk + 1]); } } }
    }
}
DI void norm_rows_bf16(const float* x, const float* w, u16* h, int nrows, int bid, int nblk) {
    const int tidw_ = opaque_tid(); const int wave = __builtin_amdgcn_readfirstlane(tidw_ >> 6), lane = tidw_ & 63;
    for (int r = bid * 8 + wave; r < nrows; r += nblk * 8) {
        const f32x4* xr = (const f32x4*)(x + (size_t)r * 1024);
        f32x4 v[4]; float ss = 0.f;
#pragma unroll
        for (int i = 0; i < 4; ++i) { v[i] = xr[lane + 64 * i]; ss += v[i][0] * v[i][0] + v[i][1] * v[i][1] + v[i][2] * v[i][2] + v[i][3] * v[i][3]; }
        ss = wave_sum(ss);
        const float rs = rsqrtf(ss * (1.f / 1024.f) + 1e-6f);
#pragma unroll
        for (int i = 0; i < 4; ++i) { const f32x4 w4 = ((const f32x4*)w)[lane + 64 * i]; u32x2 o; o.x = pk2(v[i][0] * rs * w4[0], v[i][1] * rs * w4[1]); o.y = pk2(v[i][2] * rs * w4[2], v[i][3] * rs * w4[3]);
            *(u32x2*)(h + (size_t)r * 1024 + (lane + 64 * i) * 4) = o; }
    }
}
DI void prep_rows(const float* x, const float* w, u16* h, float* ss, int bid, int nblk) {
    const int tidw_ = opaque_tid(); const int wave = __builtin_amdgcn_readfirstlane(tidw_ >> 6), lane = tidw_ & 63;
    const int stride = nblk * 8;
    f32x4 w4[4];
#pragma unroll
    for (int i = 0; i < 4; ++i) w4[i] = ((const f32x4*)w)[lane + 64 * i];
    for (int r = bid * 8 + wave; r < T_; r += 4 * stride) {
        f32x4 v[4][4];
#pragma unroll
        for (int k = 0; k < 4; ++k) { const int rr = r + k * stride < T_ ? r + k * stride : r;
#pragma unroll
            for (int i = 0; i < 4; ++i) v[k][i] = ((const f32x4*)(x + (size_t)rr * 1024))[lane + 64 * i]; }
#pragma unroll
        for (int k = 0; k < 4; ++k) { const int rr = r + k * stride; if (rr >= T_) break; float sq = 0.f;
#pragma unroll
            for (int i = 0; i < 4; ++i) sq += v[k][i][0] * v[k][i][0] + v[k][i][1] * v[k][i][1] + v[k][i][2] * v[k][i][2] + v[k][i][3] * v[k][i][3];
            sq = wave_sum(sq);
            if (lane == 0) ss[rr] = sq;
#pragma unroll
            for (int i = 0; i < 4; ++i) { u32x2 o; o.x = pk2(v[k][i][0] * w4[i][0], v[k][i][1] * w4[i][1]); o.y = pk2(v[k][i][2] * w4[i][2], v[k][i][3] * w4[i][3]);
                *(u32x2*)(h + (size_t)rr * 1024 + (lane + 64 * i) * 4) = o; } }
    }
}
DI void final_norm(float* x, const float* w, const float* ss, int bid, int nblk) {
    const int tidw_ = opaque_tid(); const int wave = __builtin_amdgcn_readfirstlane(tidw_ >> 6), lane = tidw_ & 63;
    const int stride = nblk * 8;
    f32x4 w4[4];
#pragma unroll
    for (int i = 0; i < 4; ++i) w4[i] = ((const f32x4*)w)[lane + 64 * i];
    for (int r = bid * 8 + wave; r < T_; r += 4 * stride) {
        f32x4 v[4][4]; float sq[4];
#pragma unroll
        for (int k = 0; k < 4; ++k) { const int rr = r + k * stride < T_ ? r + k * stride : r;
#pragma unroll
            for (int i = 0; i < 4; ++i) v[k][i] = ((const f32x4*)(x + (size_t)rr * 1024))[lane + 64 * i];
            sq[k] = lane < 16 ? ss[(size_t)rr * 16 + lane] : 0.f; }
#pragma unroll
        for (int k = 0; k < 4; ++k) { const int rr = r + k * stride; if (rr >= T_) break;
            const float rs = rsqrtf(wave_sum(sq[k]) * (1.f / 1024.f) + 1e-6f);
#pragma unroll
            for (int i = 0; i < 4; ++i) ((f32x4*)(x + (size_t)rr * 1024))[lane + 64 * i] = v[k][i] * rs * w4[i]; }
    }
}
DI void s5_tables(const Params& p, int j, float* sm, int bid, int nblk) {
    float* ap_re = sm; float* ap_im = ap_re + 17 * 64; float* bb_re = ap_im + 17 * 64; float* bb_im = bb_re + 1024; float* c_re = bb_im + 1024; float* c_im = c_re + 1024;
    u16* Kt = (u16*)(p.ws + WS_KT); u16* Bc = (u16*)(p.ws + WS_BC); u16* Cc = (u16*)(p.ws + WS_CC); float* a16 = (float*)(p.ws + WS_A16);
    const int tid = opaque_tid();
    for (int g = bid; g < 96; g += nblk) {
        __syncthreads();
        const int gg = j * 96 + g;
        if (tid < 64) {
            const float dt = expf(p.in[9][gg]);
            const float lr = p.in[7][gg * 64 + tid], li = p.in[8][gg * 64 + tid];
            const float mag = expf(lr * dt); float sn, cs; sincosf(li * dt, &sn, &cs);
            const float ar = mag * cs, ai = mag * sn;
            const float den = lr * lr + li * li, nr = ar - 1.f, ni = ai;
            const float cr = (nr * lr + ni * li) / den, ci = (ni * lr - nr * li) / den;
            float pr = 1.f, pi = 0.f;
            for (int q = 0; q <= 16; ++q) { ap_re[q * 64 + tid] = pr; ap_im[q * 64 + tid] = pi; const float t = pr * ar - pi * ai; pi = pr * ai + pi * ar; pr = t; }
            for (int h = 0; h < 16; ++h) { const float br = p.in[10][((size_t)gg * 64 + tid) * 16 + h], bi = p.in[11][((size_t)gg * 64 + tid) * 16 + h];
                bb_re[tid * 16 + h] = cr * br - ci * bi; bb_im[tid * 16 + h] = cr * bi + ci * br; }
        }
        for (int e = tid; e < 1024; e += 512) { c_re[e] = p.in[12][(size_t)gg * 1024 + e]; c_im[e] = p.in[13][(size_t)gg * 1024 + e]; }
        __syncthreads();
        for (int e = tid; e < 4096; e += 512) { const int lag = e >> 8, h = (e >> 4) & 15, h2 = e & 15; float s = 0.f;
            for (int pp = 0; pp < 64; ++pp) { const float cr_ = c_re[h * 64 + pp], ci_ = c_im[h * 64 + pp], ar_ = ap_re[lag * 64 + pp], ai_ = ap_im[lag * 64 + pp];
                const float mr = cr_ * ar_ - ci_ * ai_, mi = cr_ * ai_ + ci_ * ar_; s += mr * bb_re[pp * 16 + h2] - mi * bb_im[pp * 16 + h2]; }
            if (lag == 0 && h == h2) s += p.in[14][j * 1536 + g * 16 + h];
            Kt[(size_t)g * 4096 + e] = f2bf(s); }
        for (int e = tid; e < 32768; e += 512) { const int n = e >> 8, k = e & 255, s_ = k >> 4, h2 = k & 15, pp = n & 63, q = 15 - s_;
            const float ar_ = ap_re[q * 64 + pp], ai_ = ap_im[q * 64 + pp], br_ = bb_re[pp * 16 + h2], bi_ = bb_im[pp * 16 + h2];
            Bc[(size_t)g * 32768 + e] = f2bf(n < 64 ? ar_ * br_ - ai_ * bi_ : ar_ * bi_ + ai_ * br_); }
        for (int e = tid; e < 32768; e += 512) { const int n = e >> 7, k = e & 127, s_ = n >> 4, h = n & 15, pp = k & 63, q = s_ + 1;
            const float cr_ = c_re[h * 64 + pp], ci_ = c_im[h * 64 + pp], ar_ = ap_re[q * 64 + pp], ai_ = ap_im[q * 64 + pp];
            const float mr = cr_ * ar_ - ci_ * ai_, mi = cr_ * ai_ + ci_ * ar_;
            Cc[(size_t)g * 32768 + e] = f2bf(k < 64 ? mr : -mi); }
        if (tid < 64) { a16[(g * 64 + tid) * 2] = ap_re[16 * 64 + tid]; a16[(g * 64 + tid) * 2 + 1] = ap_im[16 * 64 + tid]; }
    }
}

DI bool s5_task(int it, int bid, int nblk, int& g, int& mb) {
    if (nblk == 256) { const int xcd = bid & 7, slot = bid >> 3; const int qt = (it * 8 + (slot >> 2)) * 8 + xcd; if (qt >= 192) return false; g = (qt % 24) * 4 + (slot & 3); mb = qt / 24; return true; }
    const int t = it * nblk + bid; if (t >= 768) return false; g = t % 96; mb = t / 96; return true;
}
DI void s5a_phase(const Params& p, unsigned char* smem, int bid, int nblk) {
    const u16* proj = (const u16*)(p.ws + WS_PROJ); const u16* Bc = (const u16*)(p.ws + WS_BC); float* Xloc = (float*)(p.ws + WS_XLOC);
    u16* TB = (u16*)smem;
    const int tid = opaque_tid(), wave = __builtin_amdgcn_readfirstlane(tid >> 6), lane = tid & 63, r = lane & 31, h = lane >> 5;
    int g, mb;
    for (int it = 0; s5_task(it, bid, nblk, g, mb); ++it) {
        const int chunk0 = mb * 256 + wave * 32;
        u32x4 tb[8];
#pragma unroll
        for (int q = 0; q < 8; ++q) tb[q] = *(const u32x4*)(Bc + (unsigned)(g * 32768 + (tid + q * 512) * 8));
        bf16x8 a[16];
        const u16* up = proj + (unsigned)(((chunk0 + r) * 16) * LDS5 + g * 16 + 8 * h);
#pragma unroll
        for (int s = 0; s < 16; ++s) a[s] = *(const bf16x8*)(up + (unsigned)(s * LDS5));
        __syncthreads();
#pragma unroll
        for (int q = 0; q < 8; ++q) { const int e = tid + q * 512, n = e >> 5, ch = e & 31; *(u32x4*)(TB + n * 264 + ch * 8) = tb[q]; }
        __syncthreads();
#pragma unroll
        for (int nt = 0; nt < 4; ++nt) { f32x16 acc = zero16(); const u16* bp = TB + (nt * 32 + r) * 264 + 8 * h; bf16x8 bv[16];
#pragma unroll
            for (int s = 0; s < 16; ++s) bv[s] = *(const bf16x8*)(bp + s * 16);
            __builtin_amdgcn_sched_barrier(0);
#pragma unroll
            for (int s = 0; s < 16; ++s) acc = MFMA32(a[s], bv[s], acc);
#pragma unroll
            for (int i = 0; i < 16; ++i) Xloc[(unsigned)(((chunk0 + crow(i, h)) * 96 + g) * 128 + nt * 32 + r)] = acc[i]; }
    }
}
DI void s5b_phase(const Params& p, float* sm, int bid, int nblk, bool dry) {
    float* Xloc = (float*)(p.ws + WS_XLOC); const float* a16 = (const float*)(p.ws + WS_A16);
    const int tid = opaque_tid(), pl = tid & 31, seg = tid >> 5;
    for (int item = bid; item < 768; item += nblk) {
        const int ph = item & 1, g = (item >> 1) % 96, b = item / 192; const int pp = ph * 32 + pl;
        const float ar = a16[(g * 64 + pp) * 2], ai = a16[(g * 64 + pp) * 2 + 1];
        float* base = Xloc + ((size_t)(b * 512 + seg * 32) * 96 + g) * 128 + pp;
        float yr[32], yi[32];
#pragma unroll
        for (int k = 0; k < 32; ++k) { yr[k] = base[(size_t)k * 12288]; yi[k] = base[(size_t)k * 12288 + 64]; }
#pragma unroll
        for (int k = 1; k < 32; ++k) { const float t = ar * yr[k - 1] - ai * yi[k - 1] + yr[k]; yi[k] = ar * yi[k - 1] + ai * yr[k - 1] + yi[k]; yr[k] = t; }
        float Ar = ar, Ai = ai;
#pragma unroll
        for (int q = 0; q < 5; ++q) { const float t = Ar * Ar - Ai * Ai; Ai = 2.f * Ar * Ai; Ar = t; }
        __syncthreads();
        sm[seg * 32 + pl] = yr[31]; sm[512 + seg * 32 + pl] = yi[31];
        __syncthreads();
        float cr = 0.f, ci = 0.f;
        for (int s2 = 0; s2 < seg; ++s2) { const float t = Ar * cr - Ai * ci + sm[s2 * 32 + pl]; ci = Ar * ci + Ai * cr + sm[512 + s2 * 32 + pl]; cr = t; }
        float pwr = 1.f, pwi = 0.f, prevr = 0.f, previ = 0.f;
#pragma unroll
        for (int k = 0; k < 32; ++k) { const float outr = prevr + pwr * cr - pwi * ci, outi = previ + pwr * ci + pwi * cr; prevr = yr[k]; previ = yi[k];
            if (!dry) { base[(size_t)k * 12288] = outr; base[(size_t)k * 12288 + 64] = outi; } const float t = pwr * ar - pwi * ai; pwi = pwr * ai + pwi * ar; pwr = t; }
    }
}
DI void s5c_phase(const Params& p, unsigned char* smem, int bid, int nblk, bool dry) {
    u16* proj = (u16*)(p.ws + WS_PROJ); const u16* Kt = (const u16*)(p.ws + WS_KT); const u16* Cc = (const u16*)(p.ws + WS_CC); const float* Xloc = (const float*)(p.ws + WS_XLOC);
    u16* TC = (u16*)smem; u16* TK = TC + 256 * 136;
    const int tid = opaque_tid(), wave = __builtin_amdgcn_readfirstlane(tid >> 6), lane = tid & 63, r = lane & 31, h = lane >> 5;
    int g, mb;
    for (int it = 0; s5_task(it, bid, nblk, g, mb); ++it) {
        const int chunk0 = mb * 256 + wave * 32;
        u32x4 tb[8];
#pragma unroll
        for (int q = 0; q < 8; ++q) tb[q] = *(const u32x4*)(Cc + (unsigned)(g * 32768 + (tid + q * 512) * 8));
        const u32x4 tk = *(const u32x4*)(Kt + (unsigned)(g * 4096 + tid * 8));
        bf16x8 a[16], xa[8];
        const u16* up = proj + (unsigned)(((chunk0 + r) * 16) * LDS5 + g * 16 + 8 * h);
#pragma unroll
        for (int s = 0; s < 16; ++s) a[s] = *(const bf16x8*)(up + (unsigned)(s * LDS5));
        const float* xp = Xloc + (unsigned)(((chunk0 + r) * 96 + g) * 128 + 8 * h);
#pragma unroll
        for (int s = 0; s < 8; ++s) xa[s] = pack8(*(const f32x4*)(xp + s * 16), *(const f32x4*)(xp + s * 16 + 4));
        __syncthreads();
#pragma unroll
        for (int q = 0; q < 8; ++q) { const int e = tid + q * 512, n = e >> 4, ch = e & 15; *(u32x4*)(TC + n * 136 + ch * 8) = tb[q]; }
        *(u32x4*)(TK + tid * 8) = tk;
        __syncthreads();
        const int ho = r & 15;
#pragma unroll
        for (int nt = 0; nt < 8; ++nt) { f32x16 acc = zero16(); const int so = 2 * nt + (r >> 4);
#pragma unroll
            for (int s = 0; s < 16; ++s) if (s <= 2 * nt + 1) { const int lag = so - s; bf16x8 bfr = *(const bf16x8*)(TK + (lag < 0 ? 0 : lag) * 256 + ho * 16 + 8 * h);
                if (lag < 0) bfr = (bf16x8){0, 0, 0, 0, 0, 0, 0, 0};
                acc = MFMA32(a[s], bfr, acc); }
            const u16* cp = TC + (nt * 32 + r) * 136 + 8 * h; bf16x8 cv[8];
#pragma unroll
            for (int s = 0; s < 8; ++s) cv[s] = *(const bf16x8*)(cp + s * 16);
            __builtin_amdgcn_sched_barrier(0);
#pragma unroll
            for (int s = 0; s < 8; ++s) acc = MFMA32(xa[s], cv[s], acc);
#pragma unroll
            for (int i = 0; i < 16; ++i) { const u16 val = f2bf(gelu_tanh(acc[i])); if (!dry) proj[(unsigned)(((chunk0 + crow(i, h)) * 16 + so) * LDS5 + g * 16 + ho)] = val; } }
    }
}

DI void xattn_phase(const Params& p, int layer, int ldp, int qx_col, int gx_col, unsigned char* smem, int bid, int nblk, bool dry) {
    u16* proj = (u16*)(p.ws + WS_PROJ); const u16* Km = (const u16*)(p.ws + WS_KMVT + (size_t)layer * 2 * MiB); const u16* VT = Km + 512 * 1024;
    u16* Ki = (u16*)smem; u16* Vi = Ki + 256 * 136;
    const int tid = opaque_tid(), wave = __builtin_amdgcn_readfirstlane(tid >> 6), lane = tid & 63, r = lane & 31, h = lane >> 5;
    int cur_bh = -1;
    for (int it = bid; it < 512; it += nblk) {
        const int bh = nblk == 256 ? (it & 255) >> 4 : it >> 5, qb = nblk == 256 ? (((it & 15) << 1) | (it >> 8)) : (it & 31), b = bh >> 2, hd = bh & 3;
        if (bh != cur_bh) {
            __syncthreads();
            u32x4 kq[8], vq[8];
#pragma unroll
            for (int q = 0; q < 8; ++q) { const int e = tid + q * 512; kq[q] = *(const u32x4*)(Km + (unsigned)((b * 256 + (e >> 4)) * 512 + hd * 128 + (e & 15) * 8)); vq[q] = *(const u32x4*)(VT + (unsigned)((hd * 128 + (e >> 5)) * 1024 + b * 256 + (e & 31) * 8)); }
#pragma unroll
            for (int q = 0; q < 8; ++q) { const int e = tid + q * 512; *(u32x4*)(Ki + (e >> 4) * 136 + (e & 15) * 8) = kq[q]; *(u32x4*)(Vi + (e >> 5) * 264 + (e & 31) * 8) = vq[q]; }
            __syncthreads(); cur_bh = bh;
        }
        const int q0 = b * SEQ + qb * 256 + wave * 32;
        u16* rowp = proj + (size_t)(q0 + r) * ldp;
        bf16x8 qf[8];
#pragma unroll
        for (int s = 0; s < 8; ++s) qf[s] = *(const bf16x8*)(rowp + qx_col + hd * 128 + s * 16 + 8 * h);
        f32x16 sacc[8];
#pragma unroll
        for (int kt = 0; kt < 8; ++kt) { f32x16 acc = zero16(); bf16x8 kfv[8];
#pragma unroll
            for (int s = 0; s < 8; ++s) kfv[s] = *(const bf16x8*)(Ki + (kt * 32 + r) * 136 + s * 16 + 8 * h);
            __builtin_amdgcn_sched_barrier(0);
#pragma unroll
            for (int s = 0; s < 8; ++s) acc = MFMA32(kfv[s], qf[s], acc);
            sacc[kt] = acc; }
        float mx = -3.0e38f;
#pragma unroll
        for (int kt = 0; kt < 8; ++kt)
#pragma unroll
            for (int i = 0; i < 16; ++i) mx = fmaxf(mx, sacc[kt][i]);
        mx = fmaxf(mx, __shfl_xor(mx, 32));
        const float sc = 0.08838834764831845f * 1.4426950408889634f;
        float sum = 0.f;
        bf16x8 pf[16];
#pragma unroll
        for (int kt = 0; kt < 8; ++kt) {
            f32x4 e4[4];
#pragma unroll
            for (int i = 0; i < 16; ++i) { const float pv = exp2f((sacc[kt][i] - mx) * sc); sum += pv; e4[i >> 2][i & 3] = pv; }
            pf[kt * 2] = pack8(e4[0], e4[1]); pf[kt * 2 + 1] = pack8(e4[2], e4[3]);
        }
        sum += __shfl_xor(sum, 32);
        const float inv = 1.f / sum;
        u32x2 gtv[4][4];
#pragma unroll
        for (int dt = 0; dt < 4; ++dt)
#pragma unroll
            for (int g4 = 0; g4 < 4; ++g4) gtv[dt][g4] = *(const u32x2*)(rowp + gx_col + hd * 128 + dt * 32 + 8 * g4 + 4 * h);
#pragma unroll
        for (int dt = 0; dt < 4; ++dt) { f32x16 acc = zero16();
            const u16* vrow = Vi + (dt * 32 + r) * 264 + 4 * h;
            bf16x8 vfv[16];
#pragma unroll
            for (int ks = 0; ks < 16; ++ks) vfv[ks] = cat44(*(const u32x2*)(vrow + ks * 16), *(const u32x2*)(vrow + ks * 16 + 8));
            __builtin_amdgcn_sched_barrier(0);
#pragma unroll
            for (int ks = 0; ks < 16; ++ks) acc = MFMA32(vfv[ks], pf[ks], acc);
#pragma unroll
            for (int g4 = 0; g4 < 4; ++g4) { const int d = hd * 128 + dt * 32 + 8 * g4 + 4 * h;
                const u32x2 gt = gtv[dt][g4];
                u32x2 o; o.x = pk2(acc[4 * g4] * inv * bflo(gt.x), acc[4 * g4 + 1] * inv * bfhi(gt.x)); o.y = pk2(acc[4 * g4 + 2] * inv * bflo(gt.y), acc[4 * g4 + 3] * inv * bfhi(gt.y));
                if (!dry) *(u32x2*)(rowp + qx_col + d) = o; } }
    }
}

DI void gd1_phase(const Params& p, int jl, unsigned char* smem, int bid, int nblk, int c_lo, int c_n, bool dry) {
    u16* proj = (u16*)(p.ws + WS_PROJ); const float* ab = (const float*)(p.ws + WS_AB); const u16* halo = (const u16*)(p.ws + WS_HALO);
    u16* Abuf = (u16*)(p.ws + WS_GA); u16* Mw = (u16*)(p.ws + WS_MW); float* gcG = (float*)(p.ws + WS_GC);
    const float* convw = p.in[18] + (size_t)jl * 4 * 3072; const float* a_log = p.in[19] + jl * 12; const float* dt_bias = p.in[20] + jl * 12;
    u16* qI = (u16*)smem; u16* kI = qI + 64 * 136; u16* vI = kI + 64 * 136;
    float* KK = (float*)(vI + 2 * 64 * 136); u16* Tbf = (u16*)KK;
    float* QK = KK + 64 * 65; float* Ls = QK + 64 * 65;
    float* gcS = Ls + 2 * 4096; float* btS = gcS + 128; float* bgS = btS + 128;
    const int tid = opaque_tid(), wave = __builtin_amdgcn_readfirstlane(tid >> 6), lane = tid & 63;
    for (int item = bid; item < 24 * c_n; item += nblk) {
        const int hq = item % 6, t_ = item / 6, cin = c_lo + t_ % c_n, gchunk = (t_ / c_n) * 128 + cin; const int t0 = gchunk * 64;
        __syncthreads();
        unsigned rawv[4][11]; f32x2 wv[4][4]; float betav[2][8]; float av_ = 0.f, bv_ = 0.f;
#pragma unroll
        for (int x = 0; x < 4; ++x) { const int cb = (x == 0 ? hq * 128 : x == 1 ? G_K0 + hq * 128 : G_V0 + (2 * hq + (x - 2)) * 128) + 2 * lane;
#pragma unroll
            for (int q = 0; q < 11; ++q) { const int rr = wave * 8 - 3 + q; unsigned raw = 0u;
                if (rr >= 0) raw = *(const unsigned*)(proj + (unsigned)((t0 + rr) * LDG + cb));
                else if (cin > 0) raw = *(const unsigned*)(halo + (unsigned)(((gchunk - 1) * 3 + (rr + 3)) * 3072 + cb));
                rawv[x][q] = raw; }
#pragma unroll
            for (int j = 0; j < 4; ++j) wv[x][j] = *(const f32x2*)(convw + j * 3072 + cb); }
#pragma unroll
        for (int e = 0; e < 2; ++e)
#pragma unroll
            for (int i = 0; i < 8; ++i) betav[e][i] = ab[(unsigned)((t0 + wave * 8 + i) * 24 + 12 + 2 * hq + e)];
        if (tid < 128) { const int e = tid >> 6, i = tid & 63; av_ = ab[(unsigned)((t0 + i) * 24 + 2 * hq + e)]; bv_ = ab[(unsigned)((t0 + i) * 24 + 12 + 2 * hq + e)]; }
#pragma unroll
        for (int x = 0; x < 4; ++x) {
            float res[8][2];
            float r0[11], r1[11];
#pragma unroll
            for (int q = 0; q < 11; ++q) { r0[q] = bflo(rawv[x][q]); r1[q] = bfhi(rawv[x][q]); }
#pragma unroll
            for (int i = 0; i < 8; ++i) { float s0 = 0.f, s1 = 0.f;
#pragma unroll
                for (int j = 0; j < 4; ++j) { s0 += r0[i + j] * wv[x][j][0]; s1 += r1[i + j] * wv[x][j][1]; }
                res[i][0] = silu_f(s0); res[i][1] = silu_f(s1); }
            if (x < 2) {
#pragma unroll
                for (int i = 0; i < 8; ++i) { const float ss = wave_sum(res[i][0] * res[i][0] + res[i][1] * res[i][1]);
                    const float rs = rsqrtf(ss + 1e-6f) * (x == 0 ? 0.08838834764831845f : 1.f); res[i][0] *= rs; res[i][1] *= rs; }
            }
            if (x >= 2) {
#pragma unroll
                for (int i = 0; i < 8; ++i) { const float beta = sigmoid_f(betav[x - 2][i]); res[i][0] *= beta; res[i][1] *= beta; }
            }
            u16* dstI = x == 0 ? qI : x == 1 ? kI : x == 2 ? vI : vI + 64 * 136; const int dstride = 136;
#pragma unroll
            for (int i = 0; i < 8; ++i) *(unsigned*)(dstI + (wave * 8 + i) * dstride + 2 * lane) = pk2(res[i][0], res[i][1]);
        }
        if (tid < 128) { const int e = tid >> 6, i = tid & 63, hv = 2 * hq + e;
            const float av = av_, bv = bv_;
            const float xs = av + dt_bias[hv]; const float sp = xs > 20.f ? xs : __logf(1.f + __expf(xs));
            float gv = -expf(a_log[hv]) * sp;
#pragma unroll
            for (int d = 1; d < 64; d <<= 1) { const float o = __shfl_up(gv, d); if (i >= d) gv += o; }
            const float beta = sigmoid_f(bv);
            gcS[e * 64 + i] = gv; btS[e * 64 + i] = beta; bgS[e * 64 + i] = beta * expf(gv);
            if (!dry) gcG[((size_t)gchunk * 12 + hv) * 64 + i] = gv; }
        __syncthreads();
        const int stop_ = dry ? p.dbg : 99;
        if (stop_ == 1) continue;
#pragma unroll
        for (int q = 0; q < 2; ++q) { const int e = tid + q * 512, row = e >> 4, ch = e & 15;
            const u32x4 qv_ = *(const u32x4*)(qI + row * 136 + ch * 8), kv_ = *(const u32x4*)(kI + row * 136 + ch * 8);
            if (!dry) { *(u32x4*)(proj + (size_t)(t0 + row) * LDG + hq * 128 + ch * 8) = qv_; *(u32x4*)(proj + (size_t)(t0 + row) * LDG + G_K0 + hq * 128 + ch * 8) = kv_; } }
        { const int r = lane & 31, h = lane >> 5, ti = (wave >> 1) & 1, tj = wave & 1; const u16* XI = (wave >> 2) ? qI : kI; f32x16 acc = zero16();
#pragma unroll
            for (int s = 0; s < 8; ++s) { const bf16x8 af = *(const bf16x8*)(XI + (32 * ti + r) * 136 + 16 * s + 8 * h), bfr = *(const bf16x8*)(kI + (32 * tj + r) * 136 + 16 * s + 8 * h); acc = MFMA32(af, bfr, acc); }
            float* M = (wave >> 2) ? QK : KK;
#pragma unroll
            for (int i = 0; i < 16; ++i) M[(32 * ti + crow(i, h)) * 65 + 32 * tj + r] = acc[i]; }
        __syncthreads();
        if (stop_ == 2) continue;
#pragma unroll
        for (int e = 0; e < 2; ++e) { const int hv = 2 * hq + e;
            for (int idx = tid; idx < 4096; idx += 512) { const int i = idx >> 6, j = idx & 63;
                const float dec = (i >= j) ? expf(gcS[e * 64 + i] - gcS[e * 64 + j]) : 0.f;
                Ls[e * 4096 + idx] = (i > j) ? btS[e * 64 + i] * KK[i * 65 + j] * dec : 0.f;
                const u16 av_ = f2bf(QK[i * 65 + j] * dec); if (!dry) Abuf[((size_t)gchunk * 12 + hv) * 4096 + idx] = av_; } }
        __syncthreads();
        if (stop_ == 3) continue;
        if (tid < 128) { const int e = tid >> 6, c = tid & 63, hv = 2 * hq + e; const float* Lr = Ls + e * 4096;
            float x[64];
#pragma unroll
            for (int i = 0; i < 64; ++i) { float acc = (i == c) ? 1.f : 0.f;
                float p0 = 0.f, p1 = 0.f, p2 = 0.f, p3 = 0.f;
#pragma unroll
                for (int j = 0; j < i; ++j) { const float t_ = Lr[i * 64 + j] * x[j]; if ((j & 3) == 0) p0 += t_; else if ((j & 3) == 1) p1 += t_; else if ((j & 3) == 2) p2 += t_; else p3 += t_; }
                acc -= (p0 + p1) + (p2 + p3);
                asm volatile("" : "+v"(acc) :: "memory"); x[i] = acc; }
            const float sc = bgS[e * 64 + c];
#pragma unroll
            for (int i = 0; i < 64; ++i) { Tbf[e * 4608 + i * 72 + c] = f2bf(x[i]); const u16 v_ = f2bf(x[i] * sc); if (!dry) Mw[((size_t)gchunk * 12 + hv) * 4096 + i * 64 + c] = v_; }
        }
        __syncthreads();
        { const int r = lane & 31, h = lane >> 5, e = wave >> 2, nd = wave & 3, hv = 2 * hq + e; const int li = lane & 15, rsub = (lane >> 4) & 1;
            f32x16 u0 = zero16(), u1 = zero16();
#pragma unroll
            for (int ks = 0; ks < 4; ++ks) { const u16* bp = vI + e * (64 * 136) + (16 * ks + 8 * h + (li >> 2)) * 136 + 32 * nd + 16 * rsub + 4 * (li & 3);
                const s16x4 lo = __builtin_amdgcn_ds_read_tr16_b64_v4i16((LAS s16x4*)(LAS u16*)bp), hi = __builtin_amdgcn_ds_read_tr16_b64_v4i16((LAS s16x4*)(LAS u16*)(bp + 4 * 136));
                const bf16x8 bfr = __builtin_shufflevector(lo, hi, 0, 1, 2, 3, 4, 5, 6, 7);
                const bf16x8 a0 = *(const bf16x8*)(Tbf + e * 4608 + r * 72 + 16 * ks + 8 * h), a1 = *(const bf16x8*)(Tbf + e * 4608 + (32 + r) * 72 + 16 * ks + 8 * h);
                u0 = MFMA32(a0, bfr, u0); u1 = MFMA32(a1, bfr, u1); }
            u16* up = proj + (size_t)t0 * LDG + G_V0 + hv * 128 + 32 * nd + r;
#pragma unroll
            for (int i = 0; i < 16; ++i) { const u16 w0 = f2bf(u0[i]), w1 = f2bf(u1[i]); if (!dry) { up[(size_t)crow(i, h) * LDG] = w0; up[(size_t)(32 + crow(i, h)) * LDG] = w1; } }
        }
    }
}

DI bf16x8 pk16(const f32x16& x, int s) { return pack8((f32x4){x[8 * s], x[8 * s + 1], x[8 * s + 2], x[8 * s + 3]}, (f32x4){x[8 * s + 4], x[8 * s + 5], x[8 * s + 6], x[8 * s + 7]}); }
DI bf16x8 pk16n(const f32x16& x, int s) { return pack8((f32x4){-x[8 * s], -x[8 * s + 1], -x[8 * s + 2], -x[8 * s + 3]}, (f32x4){-x[8 * s + 4], -x[8 * s + 5], -x[8 * s + 6], -x[8 * s + 7]}); }
DI void gd2_phase(const Params& p, int jl, unsigned char* smem, int bid, int nblk, int c_lo, int c_hi, bool dry) {
    u16* proj = (u16*)(p.ws + WS_PROJ); const u16* Abuf = (const u16*)(p.ws + WS_GA); const u16* Mw = (const u16*)(p.ws + WS_MW); const float* gcG = (const float*)(p.ws + WS_GC);
    const float* nw = p.in[21] + jl * 128;
    u16* knI = (u16*)smem; u16* qnI = knI + 64 * 136; u16* MwI = qnI + 64 * 136; u16* AI = MwI + 64 * 72; u16* uI = AI + 64 * 72;
    float* egS = (float*)(uI + 64 * 128); float* edS = egS + 64; float* Ob = edS + 64; float* nwS = Ob + 2 * 64 * 132;
    const int tid = opaque_tid(), wave = __builtin_amdgcn_readfirstlane(tid >> 6), lane = tid & 63, r = lane & 31, h = lane >> 5;
    const bool is_comp = wave < 4; const int dv0 = wave * 32, ht = tid - 256;
    for (int item = bid; item < 48; item += nblk) {
        const int b = item / 12, hv = item % 12, hq = hv >> 1;
        f32x16 S[4];
        float* sst = (float*)(p.ws + WS_SST) + (size_t)(item * 4 + (wave & 3)) * 4096 + lane;
#pragma unroll
        for (int i = 0; i < 4; ++i) S[i] = zero16();
        float gst = 0.f;
#define ST_SET(q, val) do { const u32x4 v_ = (val); S[(q) >> 2][((q) & 3) * 4] = __uint_as_float(v_.x); S[(q) >> 2][((q) & 3) * 4 + 1] = __uint_as_float(v_.y); S[(q) >> 2][((q) & 3) * 4 + 2] = __uint_as_float(v_.z); S[(q) >> 2][((q) & 3) * 4 + 3] = __uint_as_float(v_.w); } while (0)
#define ST_GET(q) ((u32x4){__float_as_uint(S[(q) >> 2][((q) & 3) * 4]), __float_as_uint(S[(q) >> 2][((q) & 3) * 4 + 1]), __float_as_uint(S[(q) >> 2][((q) & 3) * 4 + 2]), __float_as_uint(S[(q) >> 2][((q) & 3) * 4 + 3])})
#define GD2_LOAD(cc) do { int hl_ = ht; asm volatile("" : "+v"(hl_)); const int gch = b * 128 + (cc); const size_t t0 = (size_t)gch * 64; \
        _Pragma("unroll") for (int q = 0; q < 4; ++q) { const int e = hl_ + q * 256, row = e >> 4, ch = e & 15; const u16* rp = proj + (t0 + row) * LDG + ch * 8; \
            ST_SET(q, *(const u32x4*)(rp + G_K0 + hq * 128)); ST_SET(4 + q, *(const u32x4*)(rp + hq * 128)); ST_SET(8 + q, *(const u32x4*)(rp + G_V0 + hv * 128)); } \
        _Pragma("unroll") for (int q = 0; q < 2; ++q) { ST_SET(12 + q, *(const u32x4*)(Mw + ((size_t)gch * 12 + hv) * 4096 + (hl_ + q * 256) * 8)); ST_SET(14 + q, *(const u32x4*)(Abuf + ((size_t)gch * 12 + hv) * 4096 + (hl_ + q * 256) * 8)); } \
        if (hl_ < 64) gst = gcG[((size_t)gch * 12 + hv) * 64 + hl_]; } while (0)
#define GD2_STORE() do { int hl_ = ht; asm volatile("" : "+v"(hl_)); \
        _Pragma("unroll") for (int q = 0; q < 4; ++q) { const int e = hl_ + q * 256, row = e >> 4, ch = e & 15; \
            *(u32x4*)(knI + row * 136 + ch * 8) = ST_GET(q); *(u32x4*)(qnI + row * 136 + ch * 8) = ST_GET(4 + q); *(u32x4*)(uI + row * 128 + ch * 8) = ST_GET(8 + q); } \
        _Pragma("unroll") for (int q = 0; q < 2; ++q) { const int e = hl_ + q * 256, row = e >> 3, ch = e & 7; *(u32x4*)(MwI + row * 72 + ch * 8) = ST_GET(12 + q); *(u32x4*)(AI + row * 72 + ch * 8) = ST_GET(14 + q); } \
        if (hl_ < 64) { const float gl = __shfl(gst, 63); egS[hl_] = expf(gst); edS[hl_] = expf(gl - gst); } } while (0)
#define GD2_EPI(cc) do { int hl_ = ht; asm volatile("" : "+v"(hl_)); const int i = hl_ >> 2, sg = hl_ & 3; const float* orow = Ob + ((cc) & 1) * (64 * 132) + i * 132 + sg * 32; float ss = 0.f; \
        u16* rp = proj + (unsigned)(((b * 128 + (cc)) * 64 + i) * LDG); u32x4 GA[4]; \
        _Pragma("unroll") for (int q = 0; q < 8; ++q) { const f32x4 o = *(const f32x4*)(orow + 4 * q); ss += o[0] * o[0] + o[1] * o[1] + o[2] * o[2] + o[3] * o[3]; } \
        ss += __shfl_xor(ss, 1); ss += __shfl_xor(ss, 2); \
        const float rs = rsqrtf(ss * (1.f / 128.f) + 1e-6f); \
        _Pragma("unroll") for (int q = 0; q < 4; ++q) GA[q] = *(const u32x4*)(rp + G_GM + hv * 128 + sg * 32 + 8 * q);       \
        _Pragma("unroll") for (int q = 0; q < 4; ++q) { const u32x4 g0 = GA[q]; const f32x4 oa = *(const f32x4*)(orow + 8 * q), ob_ = *(const f32x4*)(orow + 8 * q + 4); \
            const f32x4 w0 = *(const f32x4*)(nwS + sg * 32 + 8 * q), w1 = *(const f32x4*)(nwS + sg * 32 + 8 * q + 4); u32x4 y; \
            y.x = pk2(oa[0] * rs * w0[0] * bflo(g0.x), oa[1] * rs * w0[1] * bfhi(g0.x)); y.y = pk2(oa[2] * rs * w0[2] * bflo(g0.y), oa[3] * rs * w0[3] * bfhi(g0.y)); \
            y.z = pk2(ob_[0] * rs * w1[0] * bflo(g0.z), ob_[1] * rs * w1[1] * bfhi(g0.z)); y.w = pk2(ob_[2] * rs * w1[2] * bflo(g0.w), ob_[3] * rs * w1[3] * bfhi(g0.w)); \
            if (!dry) *(u32x4*)(rp + G_V0 + hv * 128 + sg * 32 + 8 * q) = y; } } while (0)
        __syncthreads();
        if (tid < 128) nwS[tid] = nw[tid];
        if (!is_comp) { GD2_LOAD(c_lo); GD2_STORE(); }
        __syncthreads();
        if (is_comp && c_lo > 0) {
#pragma unroll
            for (int mt = 0; mt < 4; ++mt)
#pragma unroll
                for (int i = 0; i < 16; ++i) S[mt][i] = sst[(mt * 16 + i) * 64];
        }
        for (int c = c_lo; c < c_hi; ++c) {
            if (is_comp) {
                f32x16 KS[2], O[2];
#pragma unroll
                for (int mk = 0; mk < 2; ++mk) { f32x16 a1 = zero16(), a2 = zero16();
                    bf16x8 kfv[8], qfv[8];
#pragma unroll
                    for (int ks = 0; ks < 8; ++ks) { const int off = (32 * mk + r) * 136 + 16 * ks + 4 * h;
                        kfv[ks] = cat44(*(const u32x2*)(knI + off), *(const u32x2*)(knI + off + 8)); qfv[ks] = cat44(*(const u32x2*)(qnI + off), *(const u32x2*)(qnI + off + 8)); }
                    __builtin_amdgcn_sched_barrier(0);
#pragma unroll
                    for (int ks = 0; ks < 8; ++ks) { const bf16x8 sb = pk16(S[ks >> 1], ks & 1); a1 = MFMA32(kfv[ks], sb, a1); a2 = MFMA32(qfv[ks], sb, a2); }
                    KS[mk] = a1; O[mk] = a2; }
                bf16x8 KSb[4];
#pragma unroll
                for (int mk = 0; mk < 2; ++mk) { KSb[2 * mk] = pk16n(KS[mk], 0); KSb[2 * mk + 1] = pk16n(KS[mk], 1); }
                bf16x8 vnb[4], vdb[4];
#pragma unroll
                for (int mk = 0; mk < 2; ++mk) { f32x16 vn; bf16x8 mf[4];
#pragma unroll
                    for (int i = 0; i < 16; ++i) vn[i] = bf2f(uI[(32 * mk + crow(i, h)) * 128 + dv0 + r]);
#pragma unroll
                    for (int ks = 0; ks < 4; ++ks) { const int off = (32 * mk + r) * 72 + 16 * ks + 4 * h; mf[ks] = cat44(*(const u32x2*)(MwI + off), *(const u32x2*)(MwI + off + 8)); }
                    __builtin_amdgcn_sched_barrier(0);
#pragma unroll
                    for (int ks = 0; ks < 4; ++ks) vn = MFMA32(mf[ks], KSb[ks], vn);
                    vnb[2 * mk] = pk16(vn, 0); vnb[2 * mk + 1] = pk16(vn, 1);
#pragma unroll
                    for (int i = 0; i < 16; ++i) vn[i] *= edS[32 * mk + crow(i, h)];
                    vdb[2 * mk] = pk16(vn, 0); vdb[2 * mk + 1] = pk16(vn, 1); }
#pragma unroll
                for (int mk = 0; mk < 2; ++mk) { f32x16 a2 = O[mk];
                    bf16x8 af[4];
#pragma unroll
                    for (int ks = 0; ks < 4; ++ks) { const int off = (32 * mk + r) * 72 + 16 * ks + 4 * h; af[ks] = cat44(*(const u32x2*)(AI + off), *(const u32x2*)(AI + off + 8)); }
#pragma unroll
                    for (int i = 0; i < 16; ++i) a2[i] *= egS[32 * mk + crow(i, h)];
                    __builtin_amdgcn_sched_barrier(0);
#pragma unroll
                    for (int ks = 0; ks < 4; ++ks) a2 = MFMA32(af[ks], vnb[ks], a2);
                    float* ob = Ob + (c & 1) * (64 * 132);
#pragma unroll
                    for (int i = 0; i < 16; ++i) ob[(32 * mk + crow(i, h)) * 132 + dv0 + r] = a2[i]; }
                const float egl = egS[63];
                const int li = lane & 15, tq = li >> 2, tp = li & 3, rsub = (lane >> 4) & 1;
#pragma unroll
                for (int mt = 0; mt < 4; ++mt) { f32x16 a1 = S[mt];
#pragma unroll
                    for (int i = 0; i < 16; ++i) a1[i] *= egl;
                    bf16x8 tf[4];
#pragma unroll
                    for (int ks = 0; ks < 4; ++ks) { const u16* ap = knI + (16 * ks + 4 * h + tq) * 136 + 32 * mt + 16 * rsub + 4 * tp;
                        const s16x4 lo = __builtin_amdgcn_ds_read_tr16_b64_v4i16((LAS s16x4*)(LAS u16*)ap), hi = __builtin_amdgcn_ds_read_tr16_b64_v4i16((LAS s16x4*)(LAS u16*)(ap + 8 * 136));
                        tf[ks] = __builtin_shufflevector(lo, hi, 0, 1, 2, 3, 4, 5, 6, 7); }
                    __builtin_amdgcn_sched_barrier(0);
#pragma unroll
                    for (int ks = 0; ks < 4; ++ks) a1 = MFMA32(tf[ks], vdb[ks], a1);
                    S[mt] = a1; }
            } else {
                if (c + 1 < c_hi) GD2_LOAD(c + 1);
                if (c > c_lo) GD2_EPI(c - 1);
            }
            __syncthreads();
            if (!is_comp && c + 1 < c_hi) GD2_STORE();
            __syncthreads();
        }
        if (!is_comp) GD2_EPI(c_hi - 1);
        else if (c_hi < 128 && !dry) {
#pragma unroll
            for (int mt = 0; mt < 4; ++mt)
#pragma unroll
                for (int i = 0; i < 16; ++i) sst[(mt * 16 + i) * 64] = S[mt][i];
        }
#undef GD2_LOAD
#undef ST_SET
#undef ST_GET
#undef GD2_STORE
#undef GD2_EPI
    }
}

#define XB_TMO      128
#define XB_XCNT(j)  (256  + 64 * (j))
#define XB_XSUB(j)  (1280 + 64 * (j))
#define XB_XGEN(j)  (2304 + 64 * (j))
#define XB_TOP      3328
#define XB_TOPGEN   3392
#define XCD_BAR_WORDS 3456
#define XB_SPIN_CAP (1u << 18)
DI unsigned xb_ld(unsigned* p)              { return __hip_atomic_load(p, __ATOMIC_RELAXED, __HIP_MEMORY_SCOPE_AGENT); }
DI unsigned xb_add(unsigned* p, unsigned v) { return __hip_atomic_fetch_add(p, v, __ATOMIC_RELAXED, __HIP_MEMORY_SCOPE_AGENT); }
DI unsigned xb_xcc_id() { return (unsigned)__builtin_amdgcn_s_getreg((3 << 11) | 20) & 0xFu; }
#define XB_SPIN(cond, bar) do { unsigned _sp = 0; while (cond) { __builtin_amdgcn_s_sleep(1); \
    if ((++_sp & 255u) == 0u) { if (xb_ld(&(bar)[XB_TMO])) break; if (_sp > XB_SPIN_CAP) { atomicAdd(&(bar)[XB_TMO], 1u); break; } } } } while (0)
struct XcdBarrier { unsigned* bar; unsigned x; volatile LAS unsigned* st; };
DI XcdBarrier xcd_barrier_post(unsigned* bar, volatile LAS unsigned* st) {
    XcdBarrier b; b.bar = bar; b.x = xb_xcc_id(); b.st = st;
    if (threadIdx.x == 0) (void)xb_add(&bar[XB_XCNT(b.x)], 1u);
    return b;
}
DI void xcd_barrier_complete(unsigned* bar, unsigned x, unsigned& nloc, unsigned& nx) {
    const unsigned G = gridDim.x * gridDim.y * gridDim.z;
    unsigned sum, cnt, mine, sp = 0u;
    for (;;) {
        sum = 0u; cnt = 0u; mine = 0u;
#pragma unroll
        for (unsigned j = 0; j < 16; ++j) { const unsigned c = xb_ld(&bar[XB_XCNT(j)]); sum += c; cnt += (c > 0u) ? 1u : 0u; mine = (j == x) ? c : mine; }
        if (sum == G) break;
        __builtin_amdgcn_s_sleep(1);
        if ((++sp & 255u) == 0u) { if (xb_ld(&bar[XB_TMO])) break; if (sp > XB_SPIN_CAP) { atomicAdd(&bar[XB_TMO], 1u); break; } }
    }
    nloc = mine > 0u ? mine : 1u; nx = cnt > 0u ? cnt : 1u;
}
DI void xcd_barrier(const XcdBarrier& b) {
    asm volatile("s_waitcnt vmcnt(0)" ::: "memory");
    __syncthreads();
    if (threadIdx.x == 0) {
        unsigned* bar = b.bar;
        __builtin_amdgcn_s_waitcnt(0);
        unsigned nloc = b.st[0], nx = b.st[1];
        if (nloc == 0u) { xcd_barrier_complete(bar, b.x, nloc, nx); b.st[0] = nloc; b.st[1] = nx; }
        const unsigned old = xb_add(&bar[XB_XSUB(b.x)], 1u);
        const unsigned gen = old / nloc;
        if (old + 1u == (gen + 1u) * nloc) {
            __builtin_amdgcn_fence(__ATOMIC_RELEASE, "agent");
            asm volatile("s_waitcnt vmcnt(0)" ::: "memory");
            const unsigned og = xb_add(&bar[XB_TOP], 1u);
            const unsigned tg = og / nx;
            if (og + 1u == (tg + 1u) * nx) xb_add(&bar[XB_TOPGEN], 1u);
            else XB_SPIN(xb_ld(&bar[XB_TOPGEN]) == tg, bar);
            __builtin_amdgcn_fence(__ATOMIC_ACQUIRE, "agent");
            xb_add(&bar[XB_XGEN(b.x)], 1u);
            asm volatile("s_waitcnt vmcnt(0)" ::: "memory");
        } else {
            XB_SPIN(xb_ld(&bar[XB_XGEN(b.x)]) == gen, bar);
            __builtin_amdgcn_fence(__ATOMIC_ACQUIRE, "agent");
            asm volatile("s_waitcnt vmcnt(0)" ::: "memory");
        }
    }
    __syncthreads();
}

constexpr int NPIPE = 4;
constexpr int NPH_S5 = 7, NPH_GDN = NPIPE + 4, NPHASE = 2 * NPH_S5 + 2 * NPH_GDN + 1;
DI void decode_phase(int ph, int& layer, int& step) {
    if (ph < NPH_S5) { layer = 0; step = ph; } else if (ph < NPH_S5 + NPH_GDN) { layer = 1; step = ph - NPH_S5; } else if (ph < 2 * NPH_S5 + NPH_GDN) { layer = 2; step = ph - NPH_S5 - NPH_GDN; } else { layer = 3; step = ph - 2 * NPH_S5 - NPH_GDN; }
    if (layer & 1) { if (step >= 2) step = (step == NPH_GDN - 1) ? 6 : 8 + step; }
}
DI void run_phase(const Params& p, int ph, unsigned char* smem, int bid, int nblk, bool dry) {
    if (ph == NPHASE - 1) { if (!dry) final_norm(p.out, p.in[22], (const float*)(p.ws + WS_SSP), bid, nblk); return; }
    int layer, step; decode_phase(ph, layer, step);
    const bool s5 = (layer & 1) == 0; const int jl = layer >> 1;
    unsigned char* ws = p.ws;
    u16* proj = (u16*)(ws + WS_PROJ);
    LAS unsigned char* lds = (LAS unsigned char*)smem;
    const bool split = nblk > 48;
    bool do_gd2 = false, do_gd1 = false, do_xa = false; int g2_lo = 0, g2_hi = 0, g1_lo = 0, sb_bid = bid, sb_n = nblk, g2_n = nblk;
    if (s5) { do_xa = (step == 2); }
    else if (step == 10) { do_gd1 = true; g1_lo = 0; }
    else if (step > 10) {
        const int k = step - 10; const bool rec = !split || bid < 48, oth = !split || bid >= 48;
        do_gd2 = rec; g2_lo = (k - 1) * (128 / NPIPE); g2_hi = g2_lo + 128 / NPIPE; g2_n = split ? 48 : nblk;
        if (oth) { if (k < NPIPE) { do_gd1 = true; g1_lo = k * (128 / NPIPE); } else do_xa = true; if (split) { sb_bid = bid - 48; sb_n = nblk - 48; } }
    }
    if (step == 0) {
        float* tl = (float*)smem;
        if (s5 && (layer == 0 || !split)) {
                  transpose_w(p.in[6] + (size_t)jl * 1024 * 4096, 4096, (u16*)(ws + WS_WIN), 1024, 4096, 0, tl, bid, nblk);
                  transpose_w(p.in[15] + (size_t)jl * 1536 * 1536, 1536, (u16*)(ws + WS_WGLU), 1536, 1536, 0, tl, bid, nblk); }
        if (!s5)  transpose_w(p.in[17] + (size_t)jl * 1024 * 5656, 5656, (u16*)(ws + WS_WIN), 1024, NGP, 1, tl, bid, nblk);
        transpose_w(p.in[3] + (size_t)layer * 2048 * 1024, 1024, (u16*)(ws + WS_WOUT), 2048, 1024, 0, tl, bid, nblk);
        if (s5) s5_tables(p, jl, tl, bid, nblk);
        float* ssb = (float*)(ws + WS_SS);
        if (layer > 0) for (int i = bid * 512 + opaque_tid(); i < T_; i += nblk * 512) {
            const f32x4* pp = (const f32x4*)(ws + WS_SSP) + (size_t)i * 4; const f32x4 a0 = pp[0], a1 = pp[1], a2 = pp[2], a3 = pp[3];
            ssb[i] = ((a0[0] + a0[1]) + (a0[2] + a0[3])) + ((a1[0] + a1[1]) + (a1[2] + a1[3])) + ((a2[0] + a2[1]) + (a2[2] + a2[3])) + ((a3[0] + a3[1]) + (a3[2] + a3[3])); }
        if (layer == 0) {
            for (int l = 0; l < 4; ++l) { transpose_w(p.in[5] + (size_t)l * 1024 * 1024, 1024, (u16*)(ws + WS_WKV4) + (size_t)l * 1024 * 1024, 1024, 1024, 0, tl, bid, nblk);
                                          norm_rows_bf16(p.in[1], p.in[4] + l * 1024, (u16*)(ws + WS_MEMH4) + (size_t)l * 1024 * 1024, 1024, bid, nblk); }
            prep_rows(p.in[0], p.in[2], (u16*)(ws + WS_H), ssb, bid, nblk);
        }
        __syncthreads();
    }
    if (step == 1) {
        __syncthreads();
        if (s5) { pg8::Gemm g{(const u16*)(ws + WS_H), (const u16*)(ws + WS_WIN), T_, 4096, 1024, 1024}; pg8::StaticOrder S; S.init(T_, 4096, nblk, bid); EpiS5In E{proj, (const float*)(ws + WS_SS)}; pg8::gemm_phase(lds, g, S, E); }
        else    { pg8::Gemm g{(const u16*)(ws + WS_H), (const u16*)(ws + WS_WIN), T_, NGP, 1024, 1024}; pg8::StaticOrder S; S.init(T_, NGP, nblk, bid); EpiGdnIn E{proj, (float*)(ws + WS_AB), (u16*)(ws + WS_HALO), (const float*)(ws + WS_SS)}; pg8::gemm_phase(lds, g, S, E); }
        __syncthreads();
        if (layer == 0) for (int l = 0; l < 4; ++l) {
            pg8::Gemm g{(const u16*)(ws + WS_MEMH4) + (size_t)l * 1024 * 1024, (const u16*)(ws + WS_WKV4) + (size_t)l * 1024 * 1024, 1024, 1024, 1024, 1024}; pg8::StaticOrder S; S.init(1024, 1024, nblk, (bid + (nblk / 4) * l + nblk / 8) % nblk);
            EpiKV E{(u16*)(ws + WS_KMVT + (size_t)l * 2 * MiB), (u16*)(ws + WS_KMVT + (size_t)l * 2 * MiB) + 512 * 1024}; pg8::gemm_phase(lds, g, S, E); __syncthreads(); }
    }
    if (do_gd2) gd2_phase(p, jl, smem, bid, g2_n, g2_lo, g2_hi, dry);
    if (do_gd1) gd1_phase(p, jl, smem, sb_bid, sb_n, g1_lo, 128 / NPIPE, dry);
    const bool early_w = !s5 && layer == 1 && split && step == 10 + NPIPE && bid >= 48;
    if (do_xa) xattn_phase(p, layer, s5 ? LDS5 : LDG, s5 ? 3072 : G_QX, s5 ? 3584 : G_GX, smem, sb_bid, sb_n, dry);
    if (early_w) { float* tl = (float*)smem;
        transpose_w(p.in[6] + (size_t)(jl + 1) * 1024 * 4096, 4096, (u16*)(ws + WS_WIN), 1024, 4096, 0, tl, sb_bid, sb_n);
        transpose_w(p.in[15] + (size_t)(jl + 1) * 1536 * 1536, 1536, (u16*)(ws + WS_WGLU), 1536, 1536, 0, tl, sb_bid, sb_n); }
    if (s5 && step == 2) s5a_phase(p, smem, bid, nblk);
    if (s5 && step == 3) s5b_phase(p, (float*)smem, bid, nblk, dry);
    if (s5 && step == 4) s5c_phase(p, smem, bid, nblk, dry);
    if (step == 5) {
        __syncthreads();
        pg8::Gemm g{proj, (const u16*)(ws + WS_WGLU), T_, 1536, 1536, LDS5}; pg8::StaticOrder S; S.init(T_, 1536, nblk, bid); EpiGlu E{proj, p.in[16] + jl * 1536, dry}; pg8::gemm_phase(lds, g, S, E);
    }
    if (step == 6) {
        __syncthreads();
        pg8::Gemm g{proj + (s5 ? 1536 : G_V0), (const u16*)(ws + WS_WOUT), T_, 1024, 2048, s5 ? LDS5 : LDG}; pg8::StaticOrder S; S.init(T_, 1024, nblk, bid);
        EpiOut E{layer == 0 ? p.in[0] : p.out, p.out, dry, layer < 3 ? p.in[2] + (layer + 1) * 1024 : nullptr, (u16*)(ws + WS_H), (float*)(ws + WS_SSP)}; pg8::gemm_phase(lds, g, S, E);
    }
    __syncthreads();
}

__global__ void __launch_bounds__(512) fwd_megakernel(Params p) {
    extern __shared__ __attribute__((aligned(16))) unsigned char smem[];
    const int bid = blockIdx.x, nblk = gridDim.x;
#if MK_MULTI
    for (int ph = p.ph_lo; ph < p.ph_hi; ++ph) run_phase(p, ph, smem, bid, nblk, false);
#else
    cg::grid_group grid = cg::this_grid();
    volatile LAS unsigned* bst = (volatile LAS unsigned*)((LAS unsigned char*)smem + LDS_BYTES - 16);
    if (threadIdx.x < 2) bst[threadIdx.x] = 0u;
    __syncthreads();
    (void)xcd_barrier_post((unsigned*)(p.ws + WS_BAR), bst);
#define GRID_SYNC(first) do { if (first) grid.sync(); else { XcdBarrier xb_; xb_.bar = (unsigned*)(p.ws + WS_BAR); xb_.x = xb_xcc_id(); xb_.st = (volatile LAS unsigned*)((LAS unsigned char*)smem + LDS_BYTES - 16); xcd_barrier(xb_); } } while (0)
    for (int ph = p.ph_lo; ph < p.ph_hi; ++ph) {
        int lay_, st_; decode_phase(ph, lay_, st_);
        const bool dup = (ph < NPHASE - 1) && ((lay_ & 1) == p.dup_kind) && (st_ == p.dup_step);
        for (int rep_ = dup ? 0 : 1; rep_ < 2; ++rep_) { run_phase(p, ph, smem, bid, nblk, rep_ == 0); if (rep_ == 0) GRID_SYNC(false); }
        if (p.dup_step == 99) GRID_SYNC(false);
        if (ph + 1 < p.ph_hi) GRID_SYNC(ph == p.ph_lo);
    }
#endif
}

extern "C" void kernel_launch(void* const* d_in, const int* in_sizes, int n_in, void* d_out, int out_size, void* d_ws, size_t ws_size, hipStream_t stream) {
    static int grid = 0;
    if (grid == 0) {
        if (n_in != 23 || ws_size < WS_END) { fprintf(stderr, "kernel_launch: need 23 inputs and %zu bytes of workspace (got %d, %zu)\n", (size_t)WS_END, n_in, ws_size); grid = -1; return; }
        int dev = 0, cus = 0, per_cu = 0;
        hipGetDevice(&dev); hipDeviceGetAttribute(&cus, hipDeviceAttributeMultiprocessorCount, dev);
        if (hipFuncSetAttribute((const void*)fwd_megakernel, hipFuncAttributeMaxDynamicSharedMemorySize, LDS_BYTES) != hipSuccess) { fprintf(stderr, "kernel_launch: hipFuncSetAttribute failed\n"); grid = -1; return; }
        hipOccupancyMaxActiveBlocksPerMultiprocessor(&per_cu, (const void*)fwd_megakernel, 512, LDS_BYTES);
        if (per_cu < 1) { fprintf(stderr, "kernel_launch: occupancy query returned %d\n", per_cu); per_cu = 1; }
        grid = cus * (per_cu > 1 ? 1 : per_cu);
        (void)hipGetLastError();
    }
    if (grid < 0) return;
    Params p{};
    for (int i = 0; i < 23; ++i) p.in[i] = (const float*)d_in[i];
    p.out = (float*)d_out; p.ws = (unsigned char*)d_ws;
#if MK_MULTI
    for (int ph = 0; ph < NPHASE; ++ph) { p.ph_lo = ph; p.ph_hi = ph + 1; hipLaunchKernelGGL(fwd_megakernel, dim3(grid), dim3(512), LDS_BYTES, stream, p); }
#else
    p.ph_lo = 0; p.ph_hi = NPHASE; p.dup_kind = DUP_KIND; p.dup_step = DUP_STEP; p.dbg = DBG_STOP;
    if (hipMemsetAsync((char*)d_ws + WS_BAR, 0, XCD_BAR_WORDS * 4, stream) != hipSuccess) { fprintf(stderr, "kernel_launch: memset of the barrier words failed\n"); return; }
    void* args[] = {&p};
    hipError_t e = hipLaunchCooperativeKernel((const void*)fwd_megakernel, dim3(grid), dim3(512), args, LDS_BYTES, stream);
    if (e != hipSuccess) fprintf(stderr, "cooperative launch failed: %s (grid %d)\n", hipGetErrorString(e), grid);
#endif
}
```
